# Optimizing an MI355X kernel written in HIP

```python
import jax
import jax.numpy as jnp
from jax import lax
import numpy as np

D_MODEL = 1024
BATCH = 32
SEQ = 2048
DEPTH = 1

CHUNK = 64
HEAD_DIM = 64
RMS_EPS = 1e-6
NEG_INF = -1e30

SWA_Q_HEADS = 8
SWA_KV_HEADS = 2
SWA_GROUP = SWA_Q_HEADS // SWA_KV_HEADS
SWA_WINDOW = 128
SWA_WINDOW_CHUNKS = SWA_WINDOW // CHUNK
SWA_KEYS = (SWA_WINDOW_CHUNKS + 1) * CHUNK
SWA_WIDTH = SWA_Q_HEADS * HEAD_DIM
SWA_KV_WIDTH = SWA_KV_HEADS * HEAD_DIM

SB_HEADS = 8
SB_WIDTH = SB_HEADS * HEAD_DIM
SB_BLOCK = 128

N_BRANCHES = 2
SPLIT_POINTS = (
    SWA_WIDTH,
    SWA_WIDTH + SWA_KV_WIDTH,
    SWA_WIDTH + 2 * SWA_KV_WIDTH,
    SWA_WIDTH + 2 * SWA_KV_WIDTH + SB_WIDTH,
    SWA_WIDTH + 2 * SWA_KV_WIDTH + 2 * SB_WIDTH,
    SWA_WIDTH + 2 * SWA_KV_WIDTH + 3 * SB_WIDTH,
)
IN_WIDTH = SWA_WIDTH + 2 * SWA_KV_WIDTH + 3 * SB_WIDTH + N_BRANCHES * D_MODEL

PEER_HEADS = 8
PEER_N_KEYS = 128
PEER_N_EXPERTS = PEER_N_KEYS * PEER_N_KEYS
PEER_QUERY_DIM = 256
PEER_HALF = PEER_QUERY_DIM // 2
PEER_TOPK = 16
PEER_BLOCK = 128

kernel_name = 'hybrid_swa_stickbreaking_peer_block'


def rms_norm(x, gain):
    xf = x.astype(jnp.float32)
    y = xf * lax.rsqrt(jnp.mean(xf * xf, axis=-1, keepdims=True) + RMS_EPS)
    return (y * gain.astype(jnp.float32)).astype(x.dtype)


def alibi_slopes(n_heads):
    return jnp.exp2(-8.0 * jnp.arange(1, n_heads + 1, dtype=jnp.float32) / n_heads)


def sliding_window_sink_attention(q, k, v, q_gain, k_gain, sinks):
    b, s = q.shape[0], q.shape[1]
    nc = s // CHUNK
    pad = SWA_WINDOW_CHUNKS * CHUNK
    q = rms_norm(q, q_gain)
    k = rms_norm(k, k_gain)
    kp = jnp.pad(k, ((0, 0), (pad, 0), (0, 0), (0, 0))).reshape(
        b, nc + SWA_WINDOW_CHUNKS, CHUNK, SWA_KV_HEADS, HEAD_DIM)
    vp = jnp.pad(v, ((0, 0), (pad, 0), (0, 0), (0, 0))).reshape(
        b, nc + SWA_WINDOW_CHUNKS, CHUNK, SWA_KV_HEADS, HEAD_DIM)
    kw = jnp.concatenate([kp[:, i:i + nc] for i in range(SWA_WINDOW_CHUNKS + 1)], axis=2)
    vw = jnp.concatenate([vp[:, i:i + nc] for i in range(SWA_WINDOW_CHUNKS + 1)], axis=2)
    qc = q.reshape(b, nc, CHUNK, SWA_KV_HEADS, SWA_GROUP, HEAD_DIM)
    logits = jnp.einsum('bcqhgd,bckhd->bhgcqk', qc, kw).astype(jnp.float32) * (HEAD_DIM ** -0.5)
    dist = jnp.abs(jnp.arange(CHUNK)[:, None] + pad - jnp.arange(SWA_KEYS)[None, :]).astype(jnp.float32)
    slopes = alibi_slopes(SWA_Q_HEADS).reshape(SWA_KV_HEADS, SWA_GROUP)
    logits = logits - slopes[None, :, :, None, None, None] * dist
    key_pos = jnp.arange(nc)[:, None] * CHUNK - pad + jnp.arange(SWA_KEYS)[None, :]
    logits = jnp.where((key_pos >= 0)[:, None, :], logits, NEG_INF)
    sink = jnp.broadcast_to(
        sinks.astype(jnp.float32).reshape(1, SWA_KV_HEADS, SWA_GROUP, 1, 1, 1),
        logits.shape[:-1] + (1,))
    probs = jax.nn.softmax(jnp.concatenate([logits, sink], axis=-1), axis=-1)[..., :-1]
    out = jnp.einsum('bhgcqk,bckhd->bcqhgd', probs.astype(v.dtype), vw)
    return out.reshape(b, s, SWA_WIDTH)


def stick_breaking_attention(q, k, v):
    b, s, h, dh = q.shape
    nb = s // SB_BLOCK
    qb = q.reshape(b, nb, SB_BLOCK, h, dh).transpose(1, 0, 2, 3, 4)
    key_pos = jnp.arange(s)

    def block(args):
        q_blk, blk_idx = args
        z = jnp.einsum('bqhd,bkhd->bhqk', q_blk, k).astype(jnp.float32) * (dh ** -0.5)
        q_pos = blk_idx * SB_BLOCK + jnp.arange(SB_BLOCK)
        before = key_pos[None, :] < q_pos[:, None]
        log_beta = jax.nn.log_sigmoid(z)
        log_keep = jnp.where(before, jax.nn.log_sigmoid(-z), 0.0)
        suffix = lax.cumsum(log_keep, axis=3, reverse=True) - log_keep
        weights = jnp.where(before, jnp.exp(log_beta + suffix), 0.0)
        return jnp.einsum('bhqk,bkhd->bqhd', weights.astype(v.dtype), v)

    out = lax.map(block, (qb, jnp.arange(nb)))
    return out.transpose(1, 0, 2, 3, 4).reshape(b, s, h * dh)


def peer_ffn(x, w_q, sub_keys, u, v):
    b, s, d = x.shape
    tokens = x.reshape(-1, PEER_BLOCK, d)

    def block(xb):
        q = (xb @ w_q).reshape(PEER_BLOCK, PEER_HEADS, 2, PEER_HALF)
        scores = jnp.einsum('thpd,hpkd->thpk', q, sub_keys).astype(jnp.float32)
        top_s, top_i = lax.top_k(scores, PEER_TOPK)
        cand_s = (top_s[:, :, 0, :, None] + top_s[:, :, 1, None, :]).reshape(
            PEER_BLOCK, PEER_HEADS, PEER_TOPK * PEER_TOPK)
        cand_i = (top_i[:, :, 0, :, None] * PEER_N_KEYS + top_i[:, :, 1, None, :]).reshape(
            PEER_BLOCK, PEER_HEADS, PEER_TOPK * PEER_TOPK)
        best_s, best_pos = lax.top_k(cand_s, PEER_TOPK)
        expert = jnp.take_along_axis(cand_i, best_pos, axis=-1)
        gate = jax.nn.softmax(best_s, axis=-1)
        act = jax.nn.gelu(jnp.einsum('thkd,td->thk', u[expert], xb).astype(jnp.float32),
                          approximate=False)
        return jnp.einsum('thk,thkd->td', (gate * act).astype(v.dtype), v[expert])

    return lax.map(block, tokens).reshape(b, s, d)


def setup_inputs(seed: int = 0) -> dict:
    key = jax.random.key(seed)
    ks = jax.random.split(key, 16)

    def normal(k, shape, scale):
        return jax.random.normal(k, shape, jnp.float32) * scale

    return {
        'x': normal(ks[0], (BATCH, SEQ, D_MODEL), 1.0),
        'mix_norm_gain': 1.0 + normal(ks[1], (DEPTH, D_MODEL), 0.02),
        'w_in': normal(ks[2], (DEPTH, D_MODEL, IN_WIDTH), D_MODEL ** -0.5),
        'gate_bias': normal(ks[3], (DEPTH, N_BRANCHES * D_MODEL), 0.1),
        'swa_q_gain': 1.0 + normal(ks[4], (DEPTH, HEAD_DIM), 0.02),
        'swa_k_gain': 1.0 + normal(ks[5], (DEPTH, HEAD_DIM), 0.02),
        'swa_sinks': normal(ks[6], (DEPTH, SWA_Q_HEADS), 0.5),
        'w_up_swa': normal(ks[7], (DEPTH, SWA_WIDTH, D_MODEL), SWA_WIDTH ** -0.5),
        'w_up_sb': normal(ks[8], (DEPTH, SB_WIDTH, D_MODEL), SB_WIDTH ** -0.5),
        'w_out': normal(ks[9], (DEPTH, D_MODEL, D_MODEL), D_MODEL ** -0.5),
        'ffn_norm_gain': 1.0 + normal(ks[10], (DEPTH, D_MODEL), 0.02),
        'peer_w_q': normal(ks[11], (DEPTH, D_MODEL, PEER_HEADS * PEER_QUERY_DIM), D_MODEL ** -0.5),
        'peer_sub_keys': normal(ks[12], (DEPTH, PEER_HEADS, 2, PEER_N_KEYS, PEER_HALF), PEER_HALF ** -0.5),
        'peer_u': normal(ks[13], (DEPTH, PEER_N_EXPERTS, D_MODEL), D_MODEL ** -0.5),
        'peer_v': normal(ks[14], (DEPTH, PEER_N_EXPERTS, D_MODEL), PEER_HEADS ** -0.5),
    }


def reference(x, mix_norm_gain, w_in, gate_bias, swa_q_gain, swa_k_gain, swa_sinks,
              w_up_swa, w_up_sb, w_out, ffn_norm_gain, peer_w_q, peer_sub_keys, peer_u, peer_v):
    b, s, d = x.shape
    for layer in range(DEPTH):
        h = rms_norm(x, mix_norm_gain[layer])
        proj = h @ w_in[layer]
        q_a, k_a, v_a, q_b, k_b, v_b, gate_logits = jnp.split(proj, SPLIT_POINTS, axis=-1)
        y_a = sliding_window_sink_attention(
            q_a.reshape(b, s, SWA_Q_HEADS, HEAD_DIM),
            k_a.reshape(b, s, SWA_KV_HEADS, HEAD_DIM),
            v_a.reshape(b, s, SWA_KV_HEADS, HEAD_DIM),
            swa_q_gain[layer], swa_k_gain[layer], swa_sinks[layer])
        y_b = stick_breaking_attention(
            q_b.reshape(b, s, SB_HEADS, HEAD_DIM),
            k_b.reshape(b, s, SB_HEADS, HEAD_DIM),
            v_b.reshape(b, s, SB_HEADS, HEAD_DIM))
        gates = jax.nn.sigmoid(gate_logits + gate_bias[layer]).reshape(b, s, N_BRANCHES, d)
        merged = gates[:, :, 0] * (y_a @ w_up_swa[layer]) + gates[:, :, 1] * (y_b @ w_up_sb[layer])
        x = x + merged @ w_out[layer]
        h = rms_norm(x, ffn_norm_gain[layer])
        x = x + peer_ffn(h, peer_w_q[layer], peer_sub_keys[layer], peer_u[layer], peer_v[layer])
    return x
```

```cpp
#include <hip/hip_runtime.h>
#include <hip/hip_cooperative_groups.h>
#include <cstdio>
#include <cstdint>
namespace cg = cooperative_groups;

#ifndef P5_WGM
#define P5_WGM 4
#endif
#ifndef REP_PHASE
#define REP_PHASE -1
#endif
#ifndef N_LAUNCH
#define N_LAUNCH 1
#endif

namespace pg8 {
#define PG8_LAS __attribute__((address_space(3)))
typedef unsigned short bf16_t;
typedef short bf16x8 __attribute__((ext_vector_type(8)));
typedef float f32x4 __attribute__((ext_vector_type(4)));
typedef unsigned u32x4 __attribute__((ext_vector_type(4)));
typedef unsigned u32x2 __attribute__((ext_vector_type(2)));
constexpr int BM = 256, BK = 64, HALF = 128, HTB = HALF * BK * 2, STAGE_BYTES = 8 * HTB, NXCD = 8, WGM = 8;

__host__ __device__ __forceinline__ int lds_byte(int r, int c) { const int st = (r >> 4) * 2 + (c >> 5), rr = r & 15, cc = c & 31, ob = rr * 64 + cc * 2; return st * 1024 + (ob ^ (((ob >> 9) & 1) << 5)); }
__host__ __device__ __forceinline__ void stage_rc(int b, int& R, int& C) { const int st = b / 1024, sb = b % 1024, swz = sb ^ (((sb >> 9) & 1) << 5); R = (st >> 1) * 16 + swz / 64; C = (st & 1) * 32 + (swz % 64) / 2; }
__host__ __device__ __forceinline__ int perm32(int rho) { const int n = rho >> 4, i = rho & 15; return 8 * (i >> 2) + 4 * n + (i & 3); }

struct Unit { int pm, pn; };
struct Gemm { const bf16_t* A; const bf16_t* Bt; int M, N, K, lda, ldb; };

struct StaticOrder {
    int nM, nN, nwg, G, c, wgm;
    __host__ __device__ void init(int M, int N, int G_, int c_, int wgm_ = WGM) { nM = M / BM; nN = N / BM; nwg = nM * nN; G = G_; c = c_; wgm = wgm_; }
    __host__ __device__ bool next(int i, Unit& u) const {
        const long L = (long)i * G + c; if (L >= nwg) return false;
        int wgid = (int)L; { const int q = nwg / NXCD, r = nwg % NXCD, xcd = wgid % NXCD, off = wgid / NXCD; wgid = (xcd < r ? xcd * (q + 1) : r * (q + 1) + (xcd - r) * q) + off; }
        const int nig = wgm * nN, gid = wgid / nig, fm = gid * wgm, gsz = (nM - fm) < wgm ? (nM - fm) : wgm;
        u.pm = fm + ((wgid % nig) % gsz); u.pn = (wgid % nig) / gsz; return true;
    }
};

__device__ __forceinline__ unsigned cvt_pk_bf16(float lo, float hi) { unsigned r; asm volatile("v_cvt_pk_bf16_f32 %0, %1, %2" : "=v"(r) : "v"(lo), "v"(hi)); return r; }

template <class Epi, class Sched, bool CHAIN = false>
__device__ __forceinline__ void gemm_phase(PG8_LAS unsigned char* lds, const Gemm g, const Sched& S, const Epi& E, int chain_kb = 0) {
    const int tid = threadIdx.x, wid = __builtin_amdgcn_readfirstlane(tid >> 6), lane = tid & 63, wr = wid >> 2, wc = wid & 3, fr = lane & 15, fq = lane >> 4;
    const int K = g.K, nt = K / BK;
    unsigned voffA[2], voffB[2];
#pragma unroll
    for (int i = 0; i < 2; ++i) { int R, C; stage_rc(tid * 16 + i * 8192, R, C); const int Rb = Epi::PERM ? ((R & ~31) + perm32(R & 31)) : R;
        voffA[i] = (unsigned)(R * g.lda + C) * 2u; voffB[i] = (unsigned)(Rb * g.ldb + C) * 2u; }
    const size_t kstep = (size_t)(BK * 2);
    const size_t hstepA = (size_t)HALF * g.lda * 2, hstepB = (size_t)HALF * g.ldb * 2;
    const size_t tstepA = 2 * hstepA, tstepB = 2 * hstepB;
    const unsigned ldsw = (unsigned)wid * 1024u;
    const int aoff = lds_byte(wr * 64 + fr, fq * 8), boff = lds_byte(wc * 32 + fr, fq * 8);
#define PG8_SA(b, h) (((b) * 2 + (h)) * HTB)
#define PG8_SB(b, h) ((4 + (b) * 2 + (h)) * HTB)
#define PG8_STAGE(bufoff, gbase, voff) do { _Pragma("unroll") for (int _i = 0; _i < 2; ++_i) \
        __builtin_amdgcn_global_load_lds((const unsigned*)((const char*)(gbase) + (voff)[_i]), (PG8_LAS unsigned*)(lds + (bufoff) + ldsw + _i * 8192), 16, 0, 0); } while (0)
#define PG8_LDA(dst, b, h) do { _Pragma("unroll") for (int m = 0; m < 4; ++m) _Pragma("unroll") for (int k = 0; k < 2; ++k) dst[m][k] = *(const PG8_LAS bf16x8*)(lds + PG8_SA(b, h) + aoff + m * 2048 + k * 1024); } while (0)
#define PG8_LDB(dst, b, h) do { _Pragma("unroll") for (int n = 0; n < 2; ++n) _Pragma("unroll") for (int k = 0; k < 2; ++k) dst[n][k] = *(const PG8_LAS bf16x8*)(lds + PG8_SB(b, h) + boff + n * 2048 + k * 1024); } while (0)
#define PG8_MMA(ai, bj, At, Bt) do { __builtin_amdgcn_s_setprio(1); _Pragma("unroll") for (int m = 0; m < 4; ++m) _Pragma("unroll") for (int n = 0; n < 2; ++n) _Pragma("unroll") for (int k = 0; k < 2; ++k) \
        acc[ai][bj][m][n] = __builtin_amdgcn_mfma_f32_16x16x32_bf16(Bt[n][k], At[m][k], acc[ai][bj][m][n], 0, 0, 0); __builtin_amdgcn_s_setprio(0); } while (0)
#define PG8_WAIT_V(n) asm volatile("s_waitcnt vmcnt(" #n ")" ::: "memory")
#define PG8_WAIT_L(n) asm volatile("s_waitcnt lgkmcnt(" #n ")" ::: "memory")
#define PG8_BAR __builtin_amdgcn_s_barrier()
#define PG8_SCHED __builtin_amdgcn_sched_barrier(0)
    Unit cur, nxt; int ui = 0;
    if (!S.next(0, cur)) return;
    f32x4 acc[2][2][4][2];
#pragma unroll
    for (int a = 0; a < 2; ++a)
#pragma unroll
        for (int b = 0; b < 2; ++b)
#pragma unroll
            for (int m = 0; m < 4; ++m)
#pragma unroll
                for (int n = 0; n < 2; ++n) acc[a][b][m][n] = (f32x4){0.f, 0.f, 0.f, 0.f};
    bf16x8 At[4][2], B0[2][2], B1[2][2];
    const char* cA = (const char*)g.A + (size_t)cur.pm * tstepA; const char* cB = (const char*)g.Bt + (size_t)cur.pn * tstepB;
    PG8_STAGE(PG8_SB(0, 0), cB, voffB); PG8_STAGE(PG8_SB(0, 1), cB + hstepB, voffB); PG8_STAGE(PG8_SA(0, 0), cA, voffA); PG8_STAGE(PG8_SA(0, 1), cA + hstepA, voffA);
    if (wr == 1) PG8_BAR;
    PG8_WAIT_V(2); PG8_BAR;
    PG8_STAGE(PG8_SB(1, 0), cB + kstep, voffB); PG8_STAGE(PG8_SA(1, 0), cA + kstep, voffA); PG8_STAGE(PG8_SB(1, 1), cB + hstepB + kstep, voffB);
    PG8_WAIT_V(6); PG8_BAR;
#define PG8_KLOOP(nA_, nB_) do { _Pragma("unroll 1") for (int t = 0; t < nt; t += 2) { \
            const bool last = (t == nt - 2); \
            const char* a1 = cA + (size_t)(t + 1) * kstep; \
            const char* a2 = last ? (nA_) : cA + (size_t)(t + 2) * kstep; const char* b2 = last ? (nB_) : cB + (size_t)(t + 2) * kstep; \
            const char* a3 = a2 + kstep; const char* b3 = b2 + kstep; \
            PG8_LDB(B0, 0, 0); PG8_LDB(B1, 0, 1); PG8_SCHED; PG8_LDA(At, 0, 0); PG8_STAGE(PG8_SA(1, 1), a1 + hstepA, voffA); \
            PG8_WAIT_V(8); PG8_WAIT_L(0); PG8_BAR; PG8_MMA(0, 0, At, B0); PG8_MMA(0, 1, At, B1); PG8_BAR; PG8_SCHED; \
            PG8_LDA(At, 0, 1); PG8_STAGE(PG8_SB(0, 0), b2, voffB); PG8_STAGE(PG8_SB(0, 1), b2 + hstepB, voffB); PG8_STAGE(PG8_SA(0, 0), a2, voffA); \
            PG8_WAIT_V(8); PG8_WAIT_L(0); PG8_BAR; PG8_MMA(1, 0, At, B0); PG8_MMA(1, 1, At, B1); PG8_BAR; PG8_SCHED; \
            PG8_LDB(B0, 1, 0); PG8_LDB(B1, 1, 1); PG8_SCHED; PG8_LDA(At, 1, 0); PG8_STAGE(PG8_SA(0, 1), a2 + hstepA, voffA); \
            PG8_WAIT_V(8); PG8_WAIT_L(0); PG8_BAR; PG8_MMA(0, 0, At, B0); PG8_MMA(0, 1, At, B1); PG8_BAR; PG8_SCHED; \
            PG8_LDA(At, 1, 1); PG8_STAGE(PG8_SB(1, 0), b3, voffB); PG8_STAGE(PG8_SB(1, 1), b3 + hstepB, voffB); PG8_STAGE(PG8_SA(1, 0), a3, voffA); \
            PG8_WAIT_V(8); PG8_WAIT_L(0); PG8_BAR; PG8_MMA(1, 0, At, B0); PG8_MMA(1, 1, At, B1); PG8_BAR; PG8_SCHED; \
        } } while (0)
    for (;;) {
        const bool has_next = S.next(ui + 1, nxt);
        if constexpr (CHAIN) {
            const char* mA = cA + chain_kb; const char* mB = cB + chain_kb;
            PG8_KLOOP(mA, mB);
            if (wr == 0) PG8_BAR;
            E.mid(acc, cur, wr, wc, fr, fq);
            cA = mA; cB = mB;
            if (wr == 1) PG8_BAR;
        }
        const char* nA = has_next ? (const char*)g.A + (size_t)nxt.pm * tstepA : cA; const char* nB = has_next ? (const char*)g.Bt + (size_t)nxt.pn * tstepB : cB;
        PG8_KLOOP(nA, nB);
        if (wr == 0) PG8_BAR;
        E(acc, cur, wr, wc, fr, fq);
        if (!has_next) break;
#pragma unroll
        for (int a = 0; a < 2; ++a)
#pragma unroll
            for (int b = 0; b < 2; ++b)
#pragma unroll
                for (int m = 0; m < 4; ++m)
#pragma unroll
                    for (int n = 0; n < 2; ++n) acc[a][b][m][n] = (f32x4){0.f, 0.f, 0.f, 0.f};
        cur = nxt; cA = nA; cB = nB; ++ui;
        if (wr == 1) PG8_BAR;
    }
#undef PG8_KLOOP
    PG8_WAIT_V(0);
    PG8_BAR;
#undef PG8_SA
#undef PG8_SB
#undef PG8_STAGE
#undef PG8_LDA
#undef PG8_LDB
#undef PG8_MMA
#undef PG8_WAIT_V
#undef PG8_WAIT_L
#undef PG8_BAR
#undef PG8_SCHED
}

template <class Epi, class Sched>
__device__ __forceinline__ void gemm_phase_fp8(PG8_LAS unsigned char* lds, const Gemm g, const Sched& S, const Epi& E) {
    const int tid = threadIdx.x, wid = __builtin_amdgcn_readfirstlane(tid >> 6), lane = tid & 63, wr = wid >> 2, wc = wid & 3, fr = lane & 15, fq = lane >> 4;
    const int K = g.K, nt = K / BK;
    unsigned voffA[2], voffB[2];
#pragma unroll
    for (int i = 0; i < 2; ++i) { int R, C; stage_rc(tid * 16 + i * 8192, R, C); const int Rb = Epi::PERM ? ((R & ~31) + perm32(R & 31)) : R;
        voffA[i] = (unsigned)(R * g.lda + C) * 2u; voffB[i] = (unsigned)(Rb * g.ldb + C) * 2u; }
    const size_t kstep = (size_t)(BK * 2);
    const size_t hstepA = (size_t)HALF * g.lda * 2, hstepB = (size_t)HALF * g.ldb * 2;
    const size_t tstepA = 2 * hstepA, tstepB = 2 * hstepB;
    const unsigned ldsw = (unsigned)wid * 1024u;
    const int aoff = lds_byte(wr * 64 + fr, fq * 8), boff = lds_byte(wc * 32 + fr, fq * 8);
#define PG8_SA(b, h) (((b) * 2 + (h)) * HTB)
#define PG8_SB(b, h) ((4 + (b) * 2 + (h)) * HTB)
#define PG8_STAGE(bufoff, gbase, voff) do { _Pragma("unroll") for (int _i = 0; _i < 2; ++_i) \
        __builtin_amdgcn_global_load_lds((const unsigned*)((const char*)(gbase) + (voff)[_i]), (PG8_LAS unsigned*)(lds + (bufoff) + ldsw + _i * 8192), 16, 0, 0); } while (0)
#define PG8_LDA(dst, b, h) do { _Pragma("unroll") for (int m = 0; m < 4; ++m) { const i32x4_ l0_ = *(const PG8_LAS i32x4_*)(lds + PG8_SA(b, h) + aoff + m * 2048), l1_ = *(const PG8_LAS i32x4_*)(lds + PG8_SA(b, h) + aoff + m * 2048 + 1024); \
        dst[m] = __builtin_shufflevector(l0_, l1_, 0, 1, 2, 3, 4, 5, 6, 7); } } while (0)
#define PG8_LDB(dst, b, h) do { _Pragma("unroll") for (int n = 0; n < 2; ++n) { const i32x4_ l0_ = *(const PG8_LAS i32x4_*)(lds + PG8_SB(b, h) + boff + n * 2048), l1_ = *(const PG8_LAS i32x4_*)(lds + PG8_SB(b, h) + boff + n * 2048 + 1024); \
        dst[n] = __builtin_shufflevector(l0_, l1_, 0, 1, 2, 3, 4, 5, 6, 7); } } while (0)
#define PG8_MMA(ai, bj, At, Bt) do { __builtin_amdgcn_s_setprio(1); _Pragma("unroll") for (int m = 0; m < 4; ++m) _Pragma("unroll") for (int n = 0; n < 2; ++n) { \
        if constexpr (true) { asm volatile("v_mfma_scale_f32_16x16x128_f8f6f4 %0, %1, %2, %0, %3, %3 op_sel_hi:[0,0,0]" : "+v"(acc[ai][bj][m][n]) : "v"(Bt[n]), "v"(At[m]), "v"(scl_)); }     \
        else { acc[ai][bj][m][n] = __builtin_amdgcn_mfma_f32_16x16x32_bf16(__builtin_bit_cast(bf16x8, __builtin_shufflevector(Bt[n], Bt[n], 0, 1, 2, 3)), __builtin_bit_cast(bf16x8, __builtin_shufflevector(At[m], At[m], 0, 1, 2, 3)), acc[ai][bj][m][n], 0, 0, 0); \
               acc[ai][bj][m][n] = __builtin_amdgcn_mfma_f32_16x16x32_bf16(__builtin_bit_cast(bf16x8, __builtin_shufflevector(Bt[n], Bt[n], 4, 5, 6, 7)), __builtin_bit_cast(bf16x8, __builtin_shufflevector(At[m], At[m], 4, 5, 6, 7)), acc[ai][bj][m][n], 0, 0, 0); } } \
        __builtin_amdgcn_s_setprio(0); } while (0)
#define PG8_WAIT_V(n) asm volatile("s_waitcnt vmcnt(" #n ")" ::: "memory")
#define PG8_WAIT_L(n) asm volatile("s_waitcnt lgkmcnt(" #n ")" ::: "memory")
#define PG8_BAR __builtin_amdgcn_s_barrier()
#define PG8_SCHED __builtin_amdgcn_sched_barrier(0)
    Unit cur, nxt; int ui = 0;
    if (!S.next(0, cur)) return;
    f32x4 acc[2][2][4][2];
#pragma unroll
    for (int a = 0; a < 2; ++a)
#pragma unroll
        for (int b = 0; b < 2; ++b)
#pragma unroll
            for (int m = 0; m < 4; ++m)
#pragma unroll
                for (int n = 0; n < 2; ++n) acc[a][b][m][n] = (f32x4){0.f, 0.f, 0.f, 0.f};
    __builtin_amdgcn_sched_barrier(0); asm volatile("s_nop 7" ::: "memory"); __builtin_amdgcn_sched_barrier(0);
    typedef int i32x4_ __attribute__((ext_vector_type(4))); typedef int i32x8_ __attribute__((ext_vector_type(8)));
    i32x8_ At[4], B0[2], B1[2];
    int scl_ = 0x7f7f7f7f; asm volatile("" : "+v"(scl_));
    const char* cA = (const char*)g.A + (size_t)cur.pm * tstepA; const char* cB = (const char*)g.Bt + (size_t)cur.pn * tstepB;
    PG8_STAGE(PG8_SB(0, 0), cB, voffB); PG8_STAGE(PG8_SB(0, 1), cB + hstepB, voffB); PG8_STAGE(PG8_SA(0, 0), cA, voffA); PG8_STAGE(PG8_SA(0, 1), cA + hstepA, voffA);
    if (wr == 1) PG8_BAR;
    PG8_WAIT_V(2); PG8_BAR;
    PG8_STAGE(PG8_SB(1, 0), cB + kstep, voffB); PG8_STAGE(PG8_SA(1, 0), cA + kstep, voffA); PG8_STAGE(PG8_SB(1, 1), cB + hstepB + kstep, voffB);
    PG8_WAIT_V(6); PG8_BAR;
    for (;;) {
        const bool has_next = S.next(ui + 1, nxt);
        const char* nA = has_next ? (const char*)g.A + (size_t)nxt.pm * tstepA : cA; const char* nB = has_next ? (const char*)g.Bt + (size_t)nxt.pn * tstepB : cB;
#pragma unroll 1
        for (int t = 0; t < nt; t += 2) {
            const bool last = (t == nt - 2);
            const char* a1 = cA + (size_t)(t + 1) * kstep;
            const char* a2 = last ? nA : cA + (size_t)(t + 2) * kstep; const char* b2 = last ? nB : cB + (size_t)(t + 2) * kstep;
            const char* a3 = a2 + kstep; const char* b3 = b2 + kstep;
            PG8_LDB(B0, 0, 0); PG8_LDB(B1, 0, 1); PG8_SCHED; PG8_LDA(At, 0, 0); PG8_STAGE(PG8_SA(1, 1), a1 + hstepA, voffA);
            PG8_WAIT_V(8); PG8_WAIT_L(0); PG8_BAR; PG8_MMA(0, 0, At, B0); PG8_MMA(0, 1, At, B1); PG8_BAR; PG8_SCHED;
            PG8_LDA(At, 0, 1); PG8_STAGE(PG8_SB(0, 0), b2, voffB); PG8_STAGE(PG8_SB(0, 1), b2 + hstepB, voffB); PG8_STAGE(PG8_SA(0, 0), a2, voffA);
            PG8_WAIT_V(8); PG8_WAIT_L(0); PG8_BAR; PG8_MMA(1, 0, At, B0); PG8_MMA(1, 1, At, B1); PG8_BAR; PG8_SCHED;
            PG8_LDB(B0, 1, 0); PG8_LDB(B1, 1, 1); PG8_SCHED; PG8_LDA(At, 1, 0); PG8_STAGE(PG8_SA(0, 1), a2 + hstepA, voffA);
            PG8_WAIT_V(8); PG8_WAIT_L(0); PG8_BAR; PG8_MMA(0, 0, At, B0); PG8_MMA(0, 1, At, B1); PG8_BAR; PG8_SCHED;
            PG8_LDA(At, 1, 1); PG8_STAGE(PG8_SB(1, 0), b3, voffB); PG8_STAGE(PG8_SB(1, 1), b3 + hstepB, voffB); PG8_STAGE(PG8_SA(1, 0), a3, voffA);
            PG8_WAIT_V(8); PG8_WAIT_L(0); PG8_BAR; PG8_MMA(1, 0, At, B0); PG8_MMA(1, 1, At, B1); PG8_BAR; PG8_SCHED;
        }
        if (wr == 0) PG8_BAR;
        __builtin_amdgcn_sched_barrier(0); asm volatile("s_nop 15\n\ts_nop 15\n\ts_nop 15\n\ts_nop 15\n\ts_nop 15\n\ts_nop 15" ::: "memory"); __builtin_amdgcn_sched_barrier(0);
        E(acc, cur, wr, wc, fr, fq);
        if (!has_next) break;
#pragma unroll
        for (int a = 0; a < 2; ++a)
#pragma unroll
            for (int b = 0; b < 2; ++b)
#pragma unroll
                for (int m = 0; m < 4; ++m)
#pragma unroll
                    for (int n = 0; n < 2; ++n) acc[a][b][m][n] = (f32x4){0.f, 0.f, 0.f, 0.f};
        __builtin_amdgcn_sched_barrier(0); asm volatile("s_nop 7" ::: "memory"); __builtin_amdgcn_sched_barrier(0);
        cur = nxt; cA = nA; cB = nB; ++ui;
        if (wr == 1) PG8_BAR;
    }
    PG8_WAIT_V(0);
    PG8_BAR;
#undef PG8_SA
#undef PG8_SB
#undef PG8_STAGE
#undef PG8_LDA
#undef PG8_LDB
#undef PG8_MMA
#undef PG8_WAIT_V
#undef PG8_WAIT_L
#undef PG8_BAR
#undef PG8_SCHED
}
}

constexpr int D = 1024, BATCH = 32, SEQ = 2048, MTOK = BATCH * SEQ;
constexpr int N1 = 3840;
constexpr int NEXP = 16384;
constexpr float RMS_EPS = 1e-6f;
constexpr float LOG2E = 1.4426950408889634f;
constexpr float SB_EXIT = -40.f;

constexpr size_t MiB = 1u << 20;
constexpr size_t WS_W1T = 2 * MiB;
constexpr size_t WS_WVBT = 10 * MiB;
constexpr size_t WS_WUPT = 12 * MiB;
constexpr size_t WS_WOUTT = 14 * MiB;
constexpr size_t WS_WST = 16 * MiB;
constexpr size_t WS_SSQ = 20 * MiB;
constexpr size_t WS_SU = 24 * MiB;
constexpr size_t WS_SV = 25 * MiB;
constexpr size_t WS_SCT = 27 * MiB;
constexpr size_t WS_UT = 32 * MiB;
constexpr size_t WS_VT = 64 * MiB;
constexpr size_t WS_H = 96 * MiB;
constexpr size_t WS_QA = 224 * MiB;
constexpr size_t WS_KA = 288 * MiB;
constexpr size_t WS_VA = 304 * MiB;
constexpr size_t WS_QB = 320 * MiB;
constexpr size_t WS_KB = 384 * MiB;
constexpr size_t WS_VBT = 448 * MiB;
constexpr size_t WS_GATES = 512 * MiB;
constexpr size_t WS_MERGED = 768 * MiB;
constexpr size_t WS_WG8T = 28 * MiB;
constexpr size_t WS_H8 = 768 * MiB;
constexpr size_t WS_WOUT8T = 31 * MiB;
constexpr size_t WS_M8 = 224 * MiB;
constexpr size_t WS_RSTD = 26 * MiB + 512 * 1024;
constexpr size_t WS_SXR = 26 * MiB;
constexpr size_t WS_PE = 224 * MiB;
constexpr size_t WS_PG = 256 * MiB;
constexpr size_t WS_PC = 288 * MiB;
constexpr size_t WS_XQ = 320 * MiB;
constexpr size_t WS_PD = 384 * MiB;
constexpr size_t WS_END = 896 * MiB;

constexpr int LDS_BYTES = 155648;
constexpr int NTHR = 512;

#define LAS __attribute__((address_space(3)))
typedef unsigned short bf16;
typedef float f32x4 __attribute__((ext_vector_type(4)));
typedef float f32x16 __attribute__((ext_vector_type(16)));
typedef float f32x2 __attribute__((ext_vector_type(2)));
typedef short bf16x8 __attribute__((ext_vector_type(8)));
typedef unsigned u32x4 __attribute__((ext_vector_type(4)));
typedef unsigned u32x2 __attribute__((ext_vector_type(2)));
typedef __bf16 bf16v2 __attribute__((ext_vector_type(2)));

__device__ __forceinline__ unsigned f2bf(float f) { unsigned u = __builtin_bit_cast(unsigned, f); return (u + 0x7fffu + ((u >> 16) & 1u)) >> 16; }
__device__ __forceinline__ unsigned pk2(float lo, float hi) { return f2bf(lo) | (f2bf(hi) << 16); }
__device__ __forceinline__ float bflo(unsigned w) { return __builtin_bit_cast(float, w << 16); }
__device__ __forceinline__ float bfhi(unsigned w) { return __builtin_bit_cast(float, w & 0xffff0000u); }
__device__ __forceinline__ float wave_sum(float v) {
#pragma unroll
    for (int o = 1; o < 64; o <<= 1) v += __shfl_xor(v, o);
    return v;
}
__device__ __forceinline__ float dot2bf(unsigned w, unsigned x, float acc) { return __builtin_amdgcn_fdot2_f32_bf16(__builtin_bit_cast(bf16v2, w), __builtin_bit_cast(bf16v2, x), acc, false); }
__device__ __forceinline__ float fast_exp2(float x) { return __builtin_amdgcn_exp2f(x); }
__device__ __forceinline__ float fast_log2(float x) { return __builtin_amdgcn_logf(x); }
__device__ __forceinline__ float fast_rcp(float x) { return __builtin_amdgcn_rcpf(x); }
__device__ __forceinline__ float gelu_erf(float v) {
    const float av = fabsf(v), t = fast_rcp(av * 0.2316418882f + 1.0f);
    float q = t * 0.5307027145f + (-0.7265760135f); q = q * t + 0.7107068705f; q = q * t + (-0.142248368f); q = q * t + 0.127414796f; q = q * t;
    const float e = fast_exp2((v * v) * (-0.72134752044f));
    const float m = v * (q * e);
    return v < 0.f ? m : v - m;
}

struct Args { const float* in[15]; float* out; unsigned char* ws; int ph_lo, ph_hi; };

struct Ctx {
    LAS unsigned char* lds;
    int tid, lane, wave, G, bid;
    const float *x, *g1, *w_in, *gate_bias, *qgain, *kgain, *sinks, *w_up_a, *w_up_b, *w_out, *g2, *w_q, *sub_keys, *pu, *pv;
    float* out; unsigned char* ws;
};


#define XB_TMO      128
#define XB_XCNT(j)  (256  + 64 * (j))
#define XB_XSUB(j)  (1280 + 64 * (j))
#define XB_XGEN(j)  (2304 + 64 * (j))
#define XB_TOP      3328
#define XB_TOPGEN   3392
#define XCD_BAR_WORDS 3456
#define XB_SPIN_CAP (1u << 18)
__device__ __forceinline__ unsigned xb_ld(unsigned* p)              { return __hip_atomic_load(p, __ATOMIC_RELAXED, __HIP_MEMORY_SCOPE_AGENT); }
__device__ __forceinline__ unsigned xb_add(unsigned* p, unsigned v) { return __hip_atomic_fetch_add(p, v, __ATOMIC_RELAXED, __HIP_MEMORY_SCOPE_AGENT); }
__device__ __forceinline__ unsigned xb_xcc_id() { return (unsigned)__builtin_amdgcn_s_getreg((3 << 11) | 20) & 0xFu; }
#define XB_SPIN(cond, bar) do { unsigned _sp = 0; while (cond) { __builtin_amdgcn_s_sleep(1); \
    if ((++_sp & 255u) == 0u) { if (xb_ld(&(bar)[XB_TMO])) break; if (_sp > XB_SPIN_CAP) { atomicAdd(&(bar)[XB_TMO], 1u); break; } } } } while (0)
struct XcdBarrier { unsigned* bar; unsigned x; volatile __attribute__((address_space(3))) unsigned* st; };
__device__ __forceinline__ XcdBarrier xcd_barrier_post(unsigned* bar, volatile __attribute__((address_space(3))) unsigned* st) {
    XcdBarrier b; b.bar = bar; b.x = xb_xcc_id(); b.st = st;
    if (threadIdx.x == 0) (void)xb_add(&bar[XB_XCNT(b.x)], 1u);
    return b;
}
__device__ __forceinline__ void xcd_barrier_complete(unsigned* bar, unsigned x, unsigned& nloc, unsigned& nx) {
    const unsigned G = gridDim.x * gridDim.y * gridDim.z;
    unsigned sum, cnt, mine, sp = 0u;
    for (;;) {
        sum = 0u; cnt = 0u; mine = 0u;
#pragma unroll
        for (unsigned j = 0; j < 16; ++j) { const unsigned c = xb_ld(&bar[XB_XCNT(j)]); sum += c; cnt += (c > 0u) ? 1u : 0u; mine = (j == x) ? c : mine; }
        if (sum == G) break;
        __builtin_amdgcn_s_sleep(1);
        if ((++sp & 255u) == 0u) { if (xb_ld(&bar[XB_TMO])) break; if (sp > XB_SPIN_CAP) { atomicAdd(&bar[XB_TMO], 1u); break; } }
    }
    nloc = mine > 0u ? mine : 1u; nx = cnt > 0u ? cnt : 1u;
}
__device__ __forceinline__ void xcd_barrier(const XcdBarrier& b) {
    asm volatile("s_waitcnt vmcnt(0)" ::: "memory");
    __syncthreads();
    if (threadIdx.x == 0) {
        unsigned* bar = b.bar;
        __builtin_amdgcn_s_waitcnt(0);
        unsigned nloc = b.st[0], nx = b.st[1];
        if (nloc == 0u) { xcd_barrier_complete(bar, b.x, nloc, nx); b.st[0] = nloc; b.st[1] = nx; }
        const unsigned old = xb_add(&bar[XB_XSUB(b.x)], 1u);
        const unsigned gen = old / nloc;
        if (old + 1u == (gen + 1u) * nloc) {
            __builtin_amdgcn_fence(__ATOMIC_RELEASE, "agent");
            asm volatile("s_waitcnt vmcnt(0)" ::: "memory");
            const unsigned og = xb_add(&bar[XB_TOP], 1u);
            const unsigned tg = og / nx;
            if (og + 1u == (tg + 1u) * nx) xb_add(&bar[XB_TOPGEN], 1u);
            else XB_SPIN(xb_ld(&bar[XB_TOPGEN]) == tg, bar);
            __builtin_amdgcn_fence(__ATOMIC_ACQUIRE, "agent");
            xb_add(&bar[XB_XGEN(b.x)], 1u);
            asm volatile("s_waitcnt vmcnt(0)" ::: "memory");
        } else {
            XB_SPIN(xb_ld(&bar[XB_XGEN(b.x)]) == gen, bar);
            __builtin_amdgcn_fence(__ATOMIC_ACQUIRE, "agent");
            asm volatile("s_waitcnt vmcnt(0)" ::: "memory");
        }
    }
    __syncthreads();
}

__device__ __forceinline__ void transpose_item(const float* W, int ldw, int k0, int ncol0, bf16* WTrow0  , int ldt, LAS float* scr, int lane) {
#pragma unroll 8
    for (int i = 0; i < 32; ++i) { const int kk = 2 * i + (lane >> 5); scr[kk * 33 + (lane & 31)] = W[(size_t)(k0 + kk) * ldw + ncol0 + (lane & 31)]; }
    asm volatile("s_waitcnt lgkmcnt(0)" ::: "memory");
    const int c = lane & 7;
#pragma unroll
    for (int j = 0; j < 4; ++j) { const int n = (lane >> 3) + 8 * j; const LAS float* s = scr + (8 * c) * 33 + n;
        u32x4 o; o.x = pk2(s[0 * 33], s[1 * 33]); o.y = pk2(s[2 * 33], s[3 * 33]); o.z = pk2(s[4 * 33], s[5 * 33]); o.w = pk2(s[6 * 33], s[7 * 33]);
        *(u32x4*)(WTrow0 + (size_t)n * ldt + k0 + 8 * c) = o; }
    asm volatile("s_waitcnt lgkmcnt(0)" ::: "memory");
}

__device__ __forceinline__ void transpose_item_fp8(const float* W, int ldw, int k0, int ncol0, unsigned char* WTrow0, int ldt, float scale, LAS float* scr, int lane) {
#pragma unroll 8
    for (int i = 0; i < 32; ++i) { const int kk = 2 * i + (lane >> 5); scr[kk * 33 + (lane & 31)] = W[(size_t)(k0 + kk) * ldw + ncol0 + (lane & 31)]; }
    asm volatile("s_waitcnt lgkmcnt(0)" ::: "memory");
    const int n = lane >> 1, kh = (lane & 1) * 32; const LAS float* sp = scr + kh * 33 + n;
    u32x4 o0, o1;
#pragma unroll
    for (int j = 0; j < 4; ++j) { int w = __builtin_amdgcn_cvt_pk_fp8_f32(sp[(4 * j) * 33] * scale, sp[(4 * j + 1) * 33] * scale, 0, false); w = __builtin_amdgcn_cvt_pk_fp8_f32(sp[(4 * j + 2) * 33] * scale, sp[(4 * j + 3) * 33] * scale, w, true); o0[j] = (unsigned)w;
        int w2 = __builtin_amdgcn_cvt_pk_fp8_f32(sp[(16 + 4 * j) * 33] * scale, sp[(16 + 4 * j + 1) * 33] * scale, 0, false); w2 = __builtin_amdgcn_cvt_pk_fp8_f32(sp[(16 + 4 * j + 2) * 33] * scale, sp[(16 + 4 * j + 3) * 33] * scale, w2, true); o1[j] = (unsigned)w2; }
    *(u32x4*)(WTrow0 + (size_t)n * ldt + k0 + kh) = o0; *(u32x4*)(WTrow0 + (size_t)n * ldt + k0 + kh + 16) = o1;
    asm volatile("s_waitcnt lgkmcnt(0)" ::: "memory");
}

__device__ __forceinline__ void p0_prep(Ctx& F) {
    unsigned char* ws = F.ws;
    const bool prep_role = (F.bid & 3) == 3 && F.G >= 4;
    const int nprep = F.G >= 4 ? F.G / 4 : 0, nstream = F.G - nprep;
    const int sidx = F.G >= 4 ? (F.bid >> 2) * 3 + (F.bid & 3) : F.bid;
    const int gw = (prep_role ? (F.bid >> 2) : sidx) * 8 + F.wave, NGW = (prep_role ? nprep : nstream) * 8;
    if (!prep_role || F.G < 4) {
        bf16* H = (bf16*)(ws + WS_H);
        f32x4 gn[4];
#pragma unroll
        for (int j = 0; j < 4; ++j) gn[j] = *((const f32x4*)F.g1 + F.lane + 64 * j);
        for (int m4 = gw; m4 < MTOK / 4; m4 += NGW) {
            f32x4 v[4][4];
#pragma unroll
            for (int q = 0; q < 4; ++q) { const f32x4* xr = (const f32x4*)(F.x + (size_t)(m4 * 4 + q) * D) + F.lane;
#pragma unroll
                for (int j = 0; j < 4; ++j) v[q][j] = xr[64 * j]; }
            __builtin_amdgcn_sched_barrier(0);
#pragma unroll
            for (int q = 0; q < 4; ++q) { const int m = m4 * 4 + q; float s = 0.f;
#pragma unroll
                for (int j = 0; j < 4; ++j) s += (v[q][j].x * v[q][j].x + v[q][j].y * v[q][j].y) + (v[q][j].z * v[q][j].z + v[q][j].w * v[q][j].w);
                const float r = 1.0f / sqrtf(wave_sum(s) * (1.f / D) + RMS_EPS);
                u32x2* o8 = (u32x2*)(H + (size_t)m * D) + F.lane; unsigned* o4 = (unsigned*)(ws + WS_H8 + (size_t)m * D) + F.lane;
#pragma unroll
                for (int j = 0; j < 4; ++j) { const float h0 = v[q][j].x * r * gn[j].x, h1 = v[q][j].y * r * gn[j].y, h2 = v[q][j].z * r * gn[j].z, h3 = v[q][j].w * r * gn[j].w;
                    u32x2 o; o.x = pk2(h0, h1); o.y = pk2(h2, h3); o8[64 * j] = o;
                    int w8 = __builtin_amdgcn_cvt_pk_fp8_f32(h0, h1, 0, false); w8 = __builtin_amdgcn_cvt_pk_fp8_f32(h2, h3, w8, true); o4[64 * j] = (unsigned)w8; } }
        }
    }
    if (prep_role || F.G < 4) {
        LAS float* scr = (LAS float*)(F.lds + F.wave * 16384);
        bf16* W1T = (bf16*)(ws + WS_W1T); bf16* WVBT = (bf16*)(ws + WS_WVBT); bf16* WUPT = (bf16*)(ws + WS_WUPT); bf16* WOUTT = (bf16*)(ws + WS_WOUTT);
        constexpr int I_IN = 16 * 136, I_UP = 8 * 32, I_OUT = 16 * 32, NIT = I_IN + 2 * I_UP + I_OUT;
        for (int it = gw; it < NIT; it += NGW) {
            int r = it;
            if (r < I_IN) { const int kb = r / 136, nb = r % 136, n0 = nb * 32;
                if (n0 < 768 || n0 >= 2304) { transpose_item_fp8(F.w_in, 4352, kb * 64, n0, ws + WS_WG8T + (size_t)(n0 < 768 ? n0 : n0 - 2304 + 768) * D, D, 64.f, scr, F.lane); continue; }
                bf16* dst = n0 < 1792 ? W1T + (size_t)(n0 - 768) * D : WVBT + (size_t)(n0 - 1792) * D;
                transpose_item(F.w_in, 4352, kb * 64, n0, dst, D, scr, F.lane); continue; }
            r -= I_IN;
            if (r < I_UP) { const int kb = r / 32, nb = r % 32; transpose_item(F.w_up_a, D, kb * 64, nb * 32, WUPT + (size_t)(nb * 32) * D, D, scr, F.lane); continue; }
            r -= I_UP;
            if (r < I_UP) { const int kb = r / 32, nb = r % 32; transpose_item(F.w_up_b, D, kb * 64, nb * 32, WUPT + (size_t)(nb * 32) * D + 512, D, scr, F.lane); continue; }
            r -= I_UP;
            { const int kb = r / 32, nb = r % 32; transpose_item_fp8(F.w_out, D, kb * 64, nb * 32, ws + WS_WOUT8T + (size_t)(nb * 32) * D, D, 64.f, scr, F.lane); }
        }
    }
    __syncthreads();
    if (prep_role || F.G < 4) {
        bf16* WST = (bf16*)(ws + WS_WST);
        LAS float* Wq = (LAS float*)F.lds;
        LAS float* SK = (LAS float*)(F.lds + 32768);
        for (int it = (F.G >= 4 ? (F.bid >> 2) : F.bid); it < 256; it += (F.G >= 4 ? nprep : F.G)) {
            const int hp = it >> 4, kb = it & 15, k0 = kb * 64;
#pragma unroll
            for (int j = 0; j < 4; ++j) { const int r = (F.tid >> 5) + 16 * j, c4 = F.tid & 31;
                const f32x4 v = *(const f32x4*)(F.w_q + (size_t)(k0 + r) * 2048 + hp * 128 + c4 * 4);
                *(LAS f32x4*)(Wq + r * 128 + c4 * 4) = v; }
#pragma unroll
            for (int j = 0; j < 8; ++j) { const int r = (F.tid >> 5) + 16 * j, c4 = F.tid & 31;
                const f32x4 v = *(const f32x4*)(F.sub_keys + ((size_t)hp * 128 + r) * 128 + c4 * 4);
                LAS float* d = SK + r * 129 + c4 * 4; d[0] = v.x; d[1] = v.y; d[2] = v.z; d[3] = v.w; }
            __syncthreads();
            const int key = F.tid & 127, kq = F.tid >> 7;
            float a[16];
#pragma unroll
            for (int i = 0; i < 16; ++i) a[i] = 0.f;
            for (int d = 0; d < 128; ++d) { const float s = SK[key * 129 + d];
#pragma unroll
                for (int i = 0; i < 16; ++i) a[i] += Wq[(kq * 16 + i) * 128 + d] * s; }
            const float* gp = F.g2 + k0 + kq * 16;
            u32x4 o0, o1;
            o0.x = pk2(a[0] * gp[0], a[1] * gp[1]); o0.y = pk2(a[2] * gp[2], a[3] * gp[3]); o0.z = pk2(a[4] * gp[4], a[5] * gp[5]); o0.w = pk2(a[6] * gp[6], a[7] * gp[7]);
            o1.x = pk2(a[8] * gp[8], a[9] * gp[9]); o1.y = pk2(a[10] * gp[10], a[11] * gp[11]); o1.z = pk2(a[12] * gp[12], a[13] * gp[13]); o1.w = pk2(a[14] * gp[14], a[15] * gp[15]);
            u32x4* dst = (u32x4*)(WST + (size_t)(hp * 128 + key) * D + k0 + kq * 16);
            dst[0] = o0; dst[1] = o1;
            __syncthreads();
        }
    }
    if (!prep_role || F.G < 4) {
        unsigned char* UT8 = ws + WS_UT; unsigned char* VT8 = ws + WS_VT; float* SU = (float*)(ws + WS_SU); float* SV = (float*)(ws + WS_SV);
        f32x4 gn[4];
#pragma unroll
        for (int j = 0; j < 4; ++j) gn[j] = *((const f32x4*)F.g2 + F.lane * 4 + j);
        for (int e2 = gw; e2 < NEXP / 2; e2 += NGW) {
            f32x4 av[2][4], bv[2][4];
#pragma unroll
            for (int q = 0; q < 2; ++q) { const f32x4* up = (const f32x4*)(F.pu + (size_t)(e2 * 2 + q) * D) + F.lane * 4; const f32x4* vp = (const f32x4*)(F.pv + (size_t)(e2 * 2 + q) * D) + F.lane * 4;
#pragma unroll
                for (int j = 0; j < 4; ++j) { av[q][j] = up[j]; bv[q][j] = vp[j]; } }
            __builtin_amdgcn_sched_barrier(0);
#pragma unroll
            for (int q = 0; q < 2; ++q) { const int e = e2 * 2 + q;
            f32x4 a[4], b[4]; float mu = 0.f, mv = 0.f;
#pragma unroll
            for (int j = 0; j < 4; ++j) { a[j] = av[q][j] * gn[j]; b[j] = bv[q][j];
                mu = fmaxf(mu, fmaxf(fmaxf(fabsf(a[j].x), fabsf(a[j].y)), fmaxf(fabsf(a[j].z), fabsf(a[j].w))));
                mv = fmaxf(mv, fmaxf(fmaxf(fabsf(b[j].x), fabsf(b[j].y)), fmaxf(fabsf(b[j].z), fabsf(b[j].w)))); }
#pragma unroll
            for (int o = 1; o < 64; o <<= 1) { mu = fmaxf(mu, __shfl_xor(mu, o)); mv = fmaxf(mv, __shfl_xor(mv, o)); }
            const float su = mu > 0.f ? mu * (1.f / 127.f) : 1.f, sv = mv > 0.f ? mv * (1.f / 127.f) : 1.f;
            const float iu = 1.f / su, iv = 1.f / sv;
            u32x4 qu, qv;
#pragma unroll
            for (int j = 0; j < 4; ++j) {
                const int q0 = (int)rintf(a[j].x * iu), q1 = (int)rintf(a[j].y * iu), q2 = (int)rintf(a[j].z * iu), q3 = (int)rintf(a[j].w * iu);
                qu[j] = (unsigned)(q0 & 255) | ((unsigned)(q1 & 255) << 8) | ((unsigned)(q2 & 255) << 16) | ((unsigned)(q3 & 255) << 24);
                const int r0 = (int)rintf(b[j].x * iv), r1 = (int)rintf(b[j].y * iv), r2 = (int)rintf(b[j].z * iv), r3 = (int)rintf(b[j].w * iv);
                qv[j] = (unsigned)(r0 & 255) | ((unsigned)(r1 & 255) << 8) | ((unsigned)(r2 & 255) << 16) | ((unsigned)(r3 & 255) << 24); }
            { const size_t so = ((size_t)(F.lane >> 3) * NEXP + e) * 128 + (F.lane & 7) * 16;
              *(u32x4*)(UT8 + so) = qu; *(u32x4*)(VT8 + so) = qv; }
            if (F.lane == 0) { SU[e] = su; SV[e] = sv; }
            }
        }
    }
}

struct Epi1 {
    static constexpr bool PERM = true;
    unsigned char* ws; LAS const float* gate_bias; float gate_scale, out_scale;
    __device__ __forceinline__ void operator()(const f32x4 (&acc)[2][2][4][2], const pg8::Unit& u, int wr, int wc, int fr, int fq) const {
        const int row0 = u.pm * 256 + wr * 64 + fr; const int pn = u.pn;
#pragma unroll
        for (int bj = 0; bj < 2; ++bj) {
            bf16* base; int ldc, col; float sc = 1.f; bool gate = false;
            const int cin = bj * 128 + wc * 32 + 8 * fq;
            if (pn < 2) { base = (bf16*)(ws + WS_QA); ldc = 512; col = pn * 256 + cin; }
            else if (pn == 2) { base = (bf16*)(ws + (bj == 0 ? WS_KA : WS_VA)); ldc = 128; col = wc * 32 + 8 * fq; }
            else if (pn < 5) { base = (bf16*)(ws + WS_QB); ldc = 512; col = (pn - 3) * 256 + cin; sc = LOG2E * 0.125f; }
            else if (pn < 7) { base = (bf16*)(ws + WS_KB); ldc = 512; col = (pn - 5) * 256 + cin; }
            else { base = (bf16*)(ws + WS_GATES); ldc = 2048; col = (pn - 7) * 256 + cin; gate = true; }
            f32x4 b0 = {0.f, 0.f, 0.f, 0.f}, b1 = {0.f, 0.f, 0.f, 0.f};
            if (gate) { b0 = *(LAS const f32x4*)(gate_bias + col) * (-LOG2E); b1 = *(LAS const f32x4*)(gate_bias + col + 4) * (-LOG2E); }
            const float gs = -LOG2E * gate_scale;
            const size_t esz = gate ? 1 : 2, rstep = (size_t)ldc * 16 * esz;
            unsigned char* rp = (unsigned char*)base + ((size_t)row0 * ldc + col) * esz;
#pragma unroll
            for (int ai = 0; ai < 2; ++ai) {
#pragma unroll
                for (int m = 0; m < 4; ++m, rp += rstep) {
                    f32x4 v0 = acc[ai][bj][m][0], v1 = acc[ai][bj][m][1];
                    if (gate) {
                        v0 = v0 * gs + b0; v1 = v1 * gs + b1;
                        const float k_ = 1.f / 255.f; unsigned wx = 0u, wy = 0u;
#pragma unroll
                        for (int j = 0; j < 4; ++j) { const float g0 = fast_rcp(fast_exp2(v0[j]) * k_ + k_) + 0.5f, g1 = fast_rcp(fast_exp2(v1[j]) * k_ + k_) + 0.5f;
                            wx = __builtin_amdgcn_cvt_pk_u8_f32(g0, j, wx); wy = __builtin_amdgcn_cvt_pk_u8_f32(g1, j, wy); }
                        u32x2 w8; w8.x = wx; w8.y = wy;
                        *(u32x2*)rp = w8;
                    } else {
                        v0 = v0 * (sc * out_scale); v1 = v1 * (sc * out_scale);
                    u32x4 w; w.x = pg8::cvt_pk_bf16(v0[0], v0[1]); w.y = pg8::cvt_pk_bf16(v0[2], v0[3]); w.z = pg8::cvt_pk_bf16(v1[0], v1[1]); w.w = pg8::cvt_pk_bf16(v1[2], v1[3]);
                    *(u32x4*)rp = w; }
                }
                rp += 4 * rstep;
            }
        }
    }
};
struct Epi1Map { static constexpr bool PERM = true; unsigned char* ws; LAS const float* gate_bias; float gate_scale, out_scale; int thr, add_lo_hi;
    __device__ __forceinline__ void operator()(const f32x4 (&acc)[2][2][4][2], const pg8::Unit& u, int wr, int wc, int fr, int fq) const {
        pg8::Unit v = u; v.pn += (u.pn >= thr) ? (add_lo_hi >> 16) : (add_lo_hi & 0xffff); Epi1 E{ws, gate_bias, gate_scale, out_scale}; E(acc, v, wr, wc, fr, fq); } };
#define CE_(a, b) do { const unsigned _h = (a) > (b) ? (a) : (b); const unsigned _l = (a) > (b) ? (b) : (a); (a) = _h; (b) = _l; } while (0)
#define SORT16(V) do { CE_(V[0], V[1]); CE_(V[2], V[3]); CE_(V[0], V[2]); CE_(V[1], V[3]); CE_(V[1], V[2]); CE_(V[4], V[5]); CE_(V[6], V[7]); CE_(V[4], V[6]); CE_(V[5], V[7]); CE_(V[5], V[6]); CE_(V[0], V[4]); CE_(V[2], V[6]); CE_(V[2], V[4]); CE_(V[1], V[5]); CE_(V[3], V[7]); CE_(V[3], V[5]); CE_(V[1], V[2]); CE_(V[3], V[4]); CE_(V[5], V[6]); CE_(V[8], V[9]); CE_(V[10], V[11]); CE_(V[8], V[10]); CE_(V[9], V[11]); CE_(V[9], V[10]); CE_(V[12], V[13]); CE_(V[14], V[15]); CE_(V[12], V[14]); CE_(V[13], V[15]); CE_(V[13], V[14]); CE_(V[8], V[12]); CE_(V[10], V[14]); CE_(V[10], V[12]); CE_(V[9], V[13]); CE_(V[11], V[15]); CE_(V[11], V[13]); CE_(V[9], V[10]); CE_(V[11], V[12]); CE_(V[13], V[14]); CE_(V[0], V[8]); CE_(V[4], V[12]); CE_(V[4], V[8]); CE_(V[2], V[10]); CE_(V[6], V[14]); CE_(V[6], V[10]); CE_(V[2], V[4]); CE_(V[6], V[8]); CE_(V[10], V[12]); CE_(V[1], V[9]); CE_(V[5], V[13]); CE_(V[5], V[9]); CE_(V[3], V[11]); CE_(V[7], V[15]); CE_(V[7], V[11]); CE_(V[3], V[5]); CE_(V[7], V[9]); CE_(V[11], V[13]); CE_(V[1], V[2]); CE_(V[3], V[4]); CE_(V[5], V[6]); CE_(V[7], V[8]); CE_(V[9], V[10]); CE_(V[11], V[12]); CE_(V[13], V[14]); } while (0)
#define MERGE16(T, C) do { _Pragma("unroll") for (int _i = 0; _i < 16; ++_i) T[_i] = T[_i] > C[15 - _i] ? T[_i] : C[15 - _i]; CE_(T[0], T[8]); CE_(T[1], T[9]); CE_(T[2], T[10]); CE_(T[3], T[11]); CE_(T[4], T[12]); CE_(T[5], T[13]); CE_(T[6], T[14]); CE_(T[7], T[15]); CE_(T[0], T[4]); CE_(T[1], T[5]); CE_(T[2], T[6]); CE_(T[3], T[7]); CE_(T[8], T[12]); CE_(T[9], T[13]); CE_(T[10], T[14]); CE_(T[11], T[15]); CE_(T[0], T[2]); CE_(T[1], T[3]); CE_(T[4], T[6]); CE_(T[5], T[7]); CE_(T[8], T[10]); CE_(T[9], T[11]); CE_(T[12], T[14]); CE_(T[13], T[15]); CE_(T[0], T[1]); CE_(T[2], T[3]); CE_(T[4], T[5]); CE_(T[6], T[7]); CE_(T[8], T[9]); CE_(T[10], T[11]); CE_(T[12], T[13]); CE_(T[14], T[15]); } while (0)
#define INS16(T, x) do { _Pragma("unroll") for (int _i = 0; _i < 16; ++_i) { const unsigned _hi = T[_i] > (x) ? T[_i] : (x); (x) = T[_i] > (x) ? (x) : T[_i]; T[_i] = _hi; } } while (0)
__device__ __forceinline__ unsigned ord16(unsigned h) { return (h & 0x8000u) ? (~h & 0xffffu) : (h | 0x8000u); }
__device__ __forceinline__ float unord16(unsigned o) { const unsigned h = (o & 0x8000u) ? (o & 0x7fffu) : (~o & 0xffffu); return (float)__builtin_bit_cast(_Float16, (unsigned short)h); }
__device__ __forceinline__ unsigned ord32(float f) { const unsigned u = __builtin_bit_cast(unsigned, f); return (u & 0x80000000u) ? ~u : (u | 0x80000000u); }
__device__ __forceinline__ float unord32(unsigned o) { const unsigned u = (o & 0x80000000u) ? (o & 0x7fffffffu) : ~o; return __builtin_bit_cast(float, u); }

typedef short s16x2_t __attribute__((ext_vector_type(2)));
__device__ __forceinline__ unsigned pkord16(unsigned v) { const s16x2_t m = __builtin_bit_cast(s16x2_t, v) >> 15; return v ^ (__builtin_bit_cast(unsigned, m) | 0x80008000u); }

#define P6_LEVEL1(T, SV) do { _Pragma("unroll") for (int c = 0; c < 8; ++c) { const u32x4 v0 = SV[2 * c], v1 = SV[2 * c + 1]; unsigned C[16]; \
        _Pragma("unroll") for (int e = 0; e < 4; ++e) { const unsigned i0 = (unsigned)(127 - (c * 16 + e * 2)), i1 = (unsigned)(127 - (c * 16 + 8 + e * 2)); const unsigned o0 = pkord16(v0[e]), o1 = pkord16(v1[e]); \
            C[2 * e] = (o0 << 16) | i0; C[2 * e + 1] = (o0 & 0xffff0000u) | (i0 - 1u); C[8 + 2 * e] = (o1 << 16) | i1; C[8 + 2 * e + 1] = (o1 & 0xffff0000u) | (i1 - 1u); } \
        SORT16(C); \
        if (c == 0) { _Pragma("unroll") for (int i = 0; i < 16; ++i) T[i] = C[i]; } else { MERGE16(T, C); } } } while (0)

constexpr int TK_ROW = 528, TK_GRP = 16 * TK_ROW;
struct EpiTopK {
    static constexpr bool PERM = true;
    LAS unsigned char* xl; unsigned* l1k;
    __device__ __forceinline__ void operator()(const f32x4 (&acc)[2][2][4][2], const pg8::Unit& u, int wr, int wc, int fr, int fq) const {
        typedef _Float16 h2 __attribute__((ext_vector_type(2)));
        const int lane = fr + 16 * fq, w = wr * 4 + wc;
        LAS unsigned char* wp = xl + wr * TK_GRP + fr * TK_ROW + (32 * wc + 8 * fq) * 2;
        const LAS unsigned char* rp = xl + (lane >> 5) * TK_GRP + ((lane >> 1) & 15) * TK_ROW + (lane & 1) * 256;
        u32x4 sv[16];
#pragma unroll
        for (int s = 0; s < 8; ++s) {
#pragma unroll
            for (int bj = 0; bj < 2; ++bj) { const f32x4 v0 = acc[s >> 2][bj][s & 3][0], v1 = acc[s >> 2][bj][s & 3][1]; u32x4 q;
                h2 a = {(_Float16)v0[0], (_Float16)v0[1]}, b = {(_Float16)v0[2], (_Float16)v0[3]}, c = {(_Float16)v1[0], (_Float16)v1[1]}, d = {(_Float16)v1[2], (_Float16)v1[3]};
                q.x = __builtin_bit_cast(unsigned, a); q.y = __builtin_bit_cast(unsigned, b); q.z = __builtin_bit_cast(unsigned, c); q.w = __builtin_bit_cast(unsigned, d);
                *(LAS u32x4*)(wp + bj * 256) = q; }
            asm volatile("s_waitcnt lgkmcnt(0)" ::: "memory"); __builtin_amdgcn_s_barrier(); asm volatile("" ::: "memory");
            if (w == s) {
#pragma unroll
                for (int k = 0; k < 16; ++k) sv[k] = *(const LAS u32x4*)(rp + k * 16);
            }
            asm volatile("s_waitcnt lgkmcnt(0)" ::: "memory"); __builtin_amdgcn_s_barrier(); asm volatile("" ::: "memory");
        }
        unsigned T[16];
        P6_LEVEL1(T, sv);
        const size_t row = (size_t)u.pm * 256 + (w >> 2) * 128 + (lane >> 5) * 64 + (w & 3) * 16 + ((lane >> 1) & 15);
        u32x4* op = (u32x4*)(l1k + (row * 16 + u.pn * 2 + (lane & 1)) * 16);
#pragma unroll
        for (int k = 0; k < 4; ++k) { u32x4 o; o.x = T[4 * k]; o.y = T[4 * k + 1]; o.z = T[4 * k + 2]; o.w = T[4 * k + 3]; op[k] = o; }
    }
};
template <bool F16> struct EpiStore {
    static constexpr bool PERM = true;
    unsigned short* O; int ldc;
    __device__ __forceinline__ void operator()(const f32x4 (&acc)[2][2][4][2], const pg8::Unit& u, int wr, int wc, int fr, int fq) const {
        const int row0 = u.pm * 256 + wr * 64 + fr, col0 = u.pn * 256 + wc * 32 + 8 * fq;
#pragma unroll
        for (int ai = 0; ai < 2; ++ai)
#pragma unroll
            for (int m = 0; m < 4; ++m) { unsigned short* rowp = O + (size_t)(row0 + ai * 128 + m * 16) * ldc + col0;
#pragma unroll
                for (int bj = 0; bj < 2; ++bj) { const f32x4 v0 = acc[ai][bj][m][0], v1 = acc[ai][bj][m][1]; u32x4 w;
                    if (F16) {
                        typedef _Float16 h2 __attribute__((ext_vector_type(2)));
                        h2 a = {(_Float16)v0[0], (_Float16)v0[1]}, b = {(_Float16)v0[2], (_Float16)v0[3]}, c = {(_Float16)v1[0], (_Float16)v1[1]}, d = {(_Float16)v1[2], (_Float16)v1[3]};
                        w.x = __builtin_bit_cast(unsigned, a); w.y = __builtin_bit_cast(unsigned, b); w.z = __builtin_bit_cast(unsigned, c); w.w = __builtin_bit_cast(unsigned, d);
                    } else { w.x = pg8::cvt_pk_bf16(v0[0], v0[1]); w.y = pg8::cvt_pk_bf16(v0[2], v0[3]); w.z = pg8::cvt_pk_bf16(v1[0], v1[1]); w.w = pg8::cvt_pk_bf16(v1[2], v1[3]); }
                    *(u32x4*)(rowp + bj * 128) = w; } }
    }
};
template <int PASS> struct EpiUp {
    static constexpr bool PERM = true;
    bf16* merged; const bf16* gates; unsigned char* m8;
    __device__ __forceinline__ void operator()(const f32x4 (&acc)[2][2][4][2], const pg8::Unit& u, int wr, int wc, int fr, int fq) const {
        const int row0 = u.pm * 256 + wr * 64 + fr, col0 = u.pn * 256 + wc * 32 + 8 * fq;
#pragma unroll
        for (int ai = 0; ai < 2; ++ai)
#pragma unroll
            for (int m = 0; m < 4; ++m) { const size_t row = (size_t)(row0 + ai * 128 + m * 16);
#pragma unroll
                for (int bj = 0; bj < 2; ++bj) { const int col = col0 + bj * 128;
                    const u32x2 gw = *(const u32x2*)((const unsigned char*)gates + row * 2048 + PASS * 1024 + col);
                    f32x4 v0 = acc[ai][bj][m][0], v1 = acc[ai][bj][m][1];
                    { const float k_ = 1.f / 255.f; const unsigned g0_ = gw.x, g1_ = gw.y;
                      v0[0] *= (float)(g0_ & 255u) * k_; v0[1] *= (float)((g0_ >> 8) & 255u) * k_; v0[2] *= (float)((g0_ >> 16) & 255u) * k_; v0[3] *= (float)(g0_ >> 24) * k_;
                      v1[0] *= (float)(g1_ & 255u) * k_; v1[1] *= (float)((g1_ >> 8) & 255u) * k_; v1[2] *= (float)((g1_ >> 16) & 255u) * k_; v1[3] *= (float)(g1_ >> 24) * k_; }
                    u32x4* mp = (u32x4*)(merged + row * 1024 + col);
                    if (PASS == 1) { const u32x4 pw = *mp;
                        v0[0] += bflo(pw.x); v0[1] += bfhi(pw.x); v0[2] += bflo(pw.y); v0[3] += bfhi(pw.y);
                        v1[0] += bflo(pw.z); v1[1] += bfhi(pw.z); v1[2] += bflo(pw.w); v1[3] += bfhi(pw.w); }
                    if (PASS == 1) { int w0 = __builtin_amdgcn_cvt_pk_fp8_f32(v0[0], v0[1], 0, false); w0 = __builtin_amdgcn_cvt_pk_fp8_f32(v0[2], v0[3], w0, true);
                        int w1 = __builtin_amdgcn_cvt_pk_fp8_f32(v1[0], v1[1], 0, false); w1 = __builtin_amdgcn_cvt_pk_fp8_f32(v1[2], v1[3], w1, true);
                        u32x2 w8; w8.x = (unsigned)w0; w8.y = (unsigned)w1; *(u32x2*)(m8 + row * 1024 + col) = w8; }
                    else { u32x4 w; w.x = pg8::cvt_pk_bf16(v0[0], v0[1]); w.y = pg8::cvt_pk_bf16(v0[2], v0[3]); w.z = pg8::cvt_pk_bf16(v1[0], v1[1]); w.w = pg8::cvt_pk_bf16(v1[2], v1[3]);
                        *mp = w; } } }
    }
};
struct EpiUpChain {
    static constexpr bool PERM = true;
    const unsigned char* gates; unsigned char* m8;
#define EUC_LOAD(s_) do { const unsigned char* gp_ = gates + (size_t)(row0 + ((s_) >> 2) * 128 + ((s_) & 3) * 16) * 2048 + col0; \
        ga[(s_) & 3][0] = *(const u32x2*)gp_; gb[(s_) & 3][0] = *(const u32x2*)(gp_ + 1024); ga[(s_) & 3][1] = *(const u32x2*)(gp_ + 128); gb[(s_) & 3][1] = *(const u32x2*)(gp_ + 1024 + 128); } while (0)
#define EUC_RATIO(a_, b_, sh_) ((float)(((a_) >> (sh_)) & 255u) * fast_rcp(fmaxf((float)(((b_) >> (sh_)) & 255u), 1.f)))
    __device__ __forceinline__ void mid(f32x4 (&acc)[2][2][4][2], const pg8::Unit& u, int wr, int wc, int fr, int fq) const {
        const int row0 = u.pm * 256 + wr * 64 + fr, col0 = u.pn * 256 + wc * 32 + 8 * fq;
        u32x2 ga[4][2], gb[4][2];
        EUC_LOAD(0); EUC_LOAD(1); EUC_LOAD(2);
#pragma unroll
        for (int s = 0; s < 8; ++s) {
            if (s + 3 < 8) EUC_LOAD(s + 3);
            __builtin_amdgcn_sched_barrier(0);
#pragma unroll
            for (int bj = 0; bj < 2; ++bj) { const unsigned a0 = ga[s & 3][bj].x, a1 = ga[s & 3][bj].y, b0 = gb[s & 3][bj].x, b1 = gb[s & 3][bj].y;
                f32x4 r0, r1;
                r0[0] = EUC_RATIO(a0, b0, 0); r0[1] = EUC_RATIO(a0, b0, 8); r0[2] = EUC_RATIO(a0, b0, 16); r0[3] = EUC_RATIO(a0, b0, 24);
                r1[0] = EUC_RATIO(a1, b1, 0); r1[1] = EUC_RATIO(a1, b1, 8); r1[2] = EUC_RATIO(a1, b1, 16); r1[3] = EUC_RATIO(a1, b1, 24);
                acc[s >> 2][bj][s & 3][0] = acc[s >> 2][bj][s & 3][0] * r0; acc[s >> 2][bj][s & 3][1] = acc[s >> 2][bj][s & 3][1] * r1; }
            __builtin_amdgcn_sched_barrier(0);
        }
    }
#undef EUC_LOAD
#undef EUC_RATIO
    __device__ __forceinline__ void operator()(const f32x4 (&acc)[2][2][4][2], const pg8::Unit& u, int wr, int wc, int fr, int fq) const {
        const int row0 = u.pm * 256 + wr * 64 + fr, col0 = u.pn * 256 + wc * 32 + 8 * fq;
        u32x2 gb[4][2];
#define EUC_LOADB(s_) do { const unsigned char* gp_ = gates + (size_t)(row0 + ((s_) >> 2) * 128 + ((s_) & 3) * 16) * 2048 + 1024 + col0; gb[(s_) & 3][0] = *(const u32x2*)gp_; gb[(s_) & 3][1] = *(const u32x2*)(gp_ + 128); } while (0)
#define EUC_G(b_, sh_) (fmaxf((float)(((b_) >> (sh_)) & 255u), 1.f) * (1.f / 255.f))
        EUC_LOADB(0); EUC_LOADB(1); EUC_LOADB(2);
#pragma unroll
        for (int s = 0; s < 8; ++s) {
            if (s + 3 < 8) EUC_LOADB(s + 3);
            __builtin_amdgcn_sched_barrier(0);
            unsigned char* mp = m8 + (size_t)(row0 + (s >> 2) * 128 + (s & 3) * 16) * 1024 + col0;
#pragma unroll
            for (int bj = 0; bj < 2; ++bj) { const unsigned b0 = gb[s & 3][bj].x, b1 = gb[s & 3][bj].y;
                f32x4 v0 = acc[s >> 2][bj][s & 3][0], v1 = acc[s >> 2][bj][s & 3][1];
                v0[0] *= EUC_G(b0, 0); v0[1] *= EUC_G(b0, 8); v0[2] *= EUC_G(b0, 16); v0[3] *= EUC_G(b0, 24);
                v1[0] *= EUC_G(b1, 0); v1[1] *= EUC_G(b1, 8); v1[2] *= EUC_G(b1, 16); v1[3] *= EUC_G(b1, 24);
                int w0 = __builtin_amdgcn_cvt_pk_fp8_f32(v0[0], v0[1], 0, false); w0 = __builtin_amdgcn_cvt_pk_fp8_f32(v0[2], v0[3], w0, true);
                int w1 = __builtin_amdgcn_cvt_pk_fp8_f32(v1[0], v1[1], 0, false); w1 = __builtin_amdgcn_cvt_pk_fp8_f32(v1[2], v1[3], w1, true);
                u32x2 w8; w8.x = (unsigned)w0; w8.y = (unsigned)w1; *(u32x2*)(mp + bj * 128) = w8; }
            __builtin_amdgcn_sched_barrier(0);
        }
#undef EUC_LOADB
#undef EUC_G
    }
};
struct EpiOut {
    static constexpr bool PERM = false;
    const float* x; float* out; bf16* x1b; float* ssq; float ascale;
    __device__ __forceinline__ void operator()(const f32x4 (&acc)[2][2][4][2], const pg8::Unit& u, int wr, int wc, int fr, int fq) const {
        const int row0 = u.pm * 256 + wr * 64 + fr, col0 = u.pn * 256 + wc * 32 + 4 * fq;
        f32x4 xr[4][4];
#define EO_LOAD(s_) do { const float* xp_ = x + (size_t)(row0 + ((s_) >> 2) * 128 + ((s_) & 3) * 16) * D + col0; \
        xr[(s_) & 3][0] = *(const f32x4*)xp_; xr[(s_) & 3][1] = *(const f32x4*)(xp_ + 16); xr[(s_) & 3][2] = *(const f32x4*)(xp_ + 128); xr[(s_) & 3][3] = *(const f32x4*)(xp_ + 144); } while (0)
        EO_LOAD(0); EO_LOAD(1); EO_LOAD(2);
#pragma unroll
        for (int s = 0; s < 8; ++s) {
            if (s + 3 < 8) EO_LOAD(s + 3);
            __builtin_amdgcn_sched_barrier(0);
            const size_t row = (size_t)(row0 + (s >> 2) * 128 + (s & 3) * 16); const size_t off = row * D + col0; float sm = 0.f;
#pragma unroll
            for (int bj = 0; bj < 2; ++bj)
#pragma unroll
                for (int n = 0; n < 2; ++n) { const f32x4 o = xr[s & 3][bj * 2 + n] + acc[s >> 2][bj][s & 3][n] * ascale;
                    u32x2 w; w.x = pg8::cvt_pk_bf16(o[0], o[1]); w.y = pg8::cvt_pk_bf16(o[2], o[3]); *(u32x2*)(x1b + off + bj * 128 + n * 16) = w;
                    sm += (o[0] * o[0] + o[1] * o[1]) + (o[2] * o[2] + o[3] * o[3]); }
            sm += __shfl_xor(sm, 16); sm += __shfl_xor(sm, 32);
            if (fq == 0) ssq[row * 16 + u.pn * 4 + wc] = sm;
            __builtin_amdgcn_sched_barrier(0);
        }
#undef EO_LOAD
    }
};

__device__ __forceinline__ float xor32f(float x, bool upper) { const unsigned u = __builtin_bit_cast(unsigned, x); auto r = __builtin_amdgcn_permlane32_swap(u, u, false, false);
    return __builtin_bit_cast(float, upper ? r[0] : r[1]); }
constexpr int SWA_KS_STRIDE = 144;
constexpr int SWA_VT_STRIDE = 400;
constexpr int SWA_KS_OFF = 0, SWA_VT_OFF = 192 * SWA_KS_STRIDE;
__device__ __forceinline__ int pi32(int r) { return (r & 19) | ((r & 4) << 1) | ((r & 8) >> 1); }

constexpr int SWA_BUF = 192 * SWA_KS_STRIDE + 64 * SWA_VT_STRIDE;
__device__ __forceinline__ void swa_phase(Ctx& F) {
    unsigned char* ws = F.ws;
    const bf16* QA = (const bf16*)(ws + WS_QA); const bf16* KA = (const bf16*)(ws + WS_KA); const bf16* VA = (const bf16*)(ws + WS_VA);
    bf16* Y = (bf16*)(ws + WS_H);
    const int lane = F.lane, l31 = lane & 31, hh = lane >> 5, wave = F.wave;
    LAS float* GQ = (LAS float*)(F.lds + 2 * SWA_BUF);
    if (F.tid < 64) GQ[F.tid] = F.qgain[F.tid] * F.kgain[F.tid];
    __syncthreads();
    constexpr int NU = BATCH * 32 * 2;
    const int skey = F.tid >> 1, shalf = F.tid & 1, hq = wave >> 1, qh = wave & 1;
    const float sk0 = F.sinks[hq] * LOG2E, sk1 = F.sinks[4 + hq] * LOG2E;
    u32x4 kv[4], vv[4], qv[4];
#define SWA_GLOAD(unit_) do { const int g_ = (unit_) & 1, c_ = ((unit_) >> 1) & 31, b_ = (unit_) >> 6; \
        if (F.tid < 384) { const int p_ = c_ * 64 - 128 + skey; \
            if (p_ >= 0) { const size_t tok_ = (size_t)b_ * SEQ + p_; \
                const u32x4* kp_ = (const u32x4*)(KA + tok_ * 128 + g_ * 64 + shalf * 32); const u32x4* vp_ = (const u32x4*)(VA + tok_ * 128 + g_ * 64 + shalf * 32); \
                _Pragma("unroll") for (int j = 0; j < 4; ++j) { kv[j] = kp_[j]; vv[j] = vp_[j]; } \
            } else { _Pragma("unroll") for (int j = 0; j < 4; ++j) { kv[j] = (u32x4){0u, 0u, 0u, 0u}; vv[j] = (u32x4){0u, 0u, 0u, 0u}; } } } \
        { const size_t tokq_ = (size_t)b_ * SEQ + c_ * 64 + qh * 32 + l31; const u32x4* qp_ = (const u32x4*)(QA + tokq_ * 512 + (g_ * 4 + hq) * 64 + hh * 32); \
          _Pragma("unroll") for (int j = 0; j < 4; ++j) qv[j] = qp_[j]; } } while (0)
    if ((int)F.bid < NU) SWA_GLOAD((int)F.bid);
    int buf = 0;
    for (int unit = F.bid; unit < NU; unit += F.G, buf ^= 1) {
        const int g = unit & 1, c = (unit >> 1) & 31, b = unit >> 6;
        LAS unsigned char* Ks = F.lds + buf * SWA_BUF + SWA_KS_OFF; LAS unsigned char* Vt = F.lds + buf * SWA_BUF + SWA_VT_OFF;
        if (F.tid < 384) {
            const int key = skey, half = shalf;
            float s = 0.f;
#pragma unroll
            for (int j = 0; j < 4; ++j)
#pragma unroll
                for (int e = 0; e < 4; ++e) { const float a = bflo(kv[j][e]), bb = bfhi(kv[j][e]); s += a * a + bb * bb; }
            s += __shfl_xor(s, 1);
            const float r = 1.0f / sqrtf(s * (1.f / 64.f) + RMS_EPS);
#pragma unroll
            for (int j = 0; j < 4; ++j) { u32x4 o;
#pragma unroll
                for (int e = 0; e < 4; ++e) o[e] = pk2(bflo(kv[j][e]) * r, bfhi(kv[j][e]) * r);
                *(LAS u32x4*)(Ks + key * SWA_KS_STRIDE + half * 64 + j * 16) = o; }
#pragma unroll
            for (int j = 0; j < 4; ++j)
#pragma unroll
                for (int e = 0; e < 4; ++e) { const int d = half * 32 + j * 8 + e * 2;
                    *(LAS unsigned short*)(Vt + d * SWA_VT_STRIDE + key * 2) = (unsigned short)(vv[j][e] & 0xffffu);
                    *(LAS unsigned short*)(Vt + (d + 1) * SWA_VT_STRIDE + key * 2) = (unsigned short)(vv[j][e] >> 16); }
        }
        const int head = g * 4 + hq;
        const int qi = qh * 32 + l31;
        const size_t tok = (size_t)b * SEQ + c * 64 + qi;
        bf16x8 qf[4];
        {
            float s = 0.f;
#pragma unroll
            for (int j = 0; j < 4; ++j) {
#pragma unroll
                for (int e = 0; e < 4; ++e) { const float a = bflo(qv[j][e]), bb = bfhi(qv[j][e]); s += a * a + bb * bb; } }
            s += xor32f(s, hh != 0);
            const float r = (1.0f / sqrtf(s * (1.f / 64.f) + RMS_EPS)) * (0.125f * LOG2E);
#pragma unroll
            for (int j = 0; j < 4; ++j) { u32x4 o; const f32x4 ga = *(LAS const f32x4*)(GQ + hh * 32 + j * 8), gb = *(LAS const f32x4*)(GQ + hh * 32 + j * 8 + 4);
                o[0] = pk2(bflo(qv[j][0]) * (ga[0] * r), bfhi(qv[j][0]) * (ga[1] * r)); o[1] = pk2(bflo(qv[j][1]) * (ga[2] * r), bfhi(qv[j][1]) * (ga[3] * r));
                o[2] = pk2(bflo(qv[j][2]) * (gb[0] * r), bfhi(qv[j][2]) * (gb[1] * r)); o[3] = pk2(bflo(qv[j][3]) * (gb[2] * r), bfhi(qv[j][3]) * (gb[3] * r));
                qf[j] = __builtin_bit_cast(bf16x8, o); }
        }
        __builtin_amdgcn_sched_barrier(0);
        { const int nu = unit + (int)F.G; if (nu < NU) SWA_GLOAD(nu); }
        __builtin_amdgcn_sched_barrier(0);
        __syncthreads();
        const float slope = exp2f(-(float)(head + 1)) * LOG2E;
        const float sinkl = g ? sk1 : sk0;
        float mrun = sinkl, lsum = 1.0f;
        f32x16 o0 = {0.f, 0.f, 0.f, 0.f, 0.f, 0.f, 0.f, 0.f, 0.f, 0.f, 0.f, 0.f, 0.f, 0.f, 0.f, 0.f}, o1 = o0;
#pragma unroll 1
        for (int tt = (c < 2 ? 4 - 2 * c : 0); tt < 6; ++tt) {
            f32x16 a = {0.f, 0.f, 0.f, 0.f, 0.f, 0.f, 0.f, 0.f, 0.f, 0.f, 0.f, 0.f, 0.f, 0.f, 0.f, 0.f};
            const LAS unsigned char* kp = Ks + (tt * 32 + pi32(l31)) * SWA_KS_STRIDE + hh * 64;
#pragma unroll
            for (int ks = 0; ks < 4; ++ks) { const bf16x8 kf = *(const LAS bf16x8*)(kp + ks * 16); a = __builtin_amdgcn_mfma_f32_32x32x16_bf16(kf, qf[ks], a, 0, 0, 0); }
            float tmax = -1e30f;
            const float dbase = (float)(qi + 128 - tt * 32 - 8 * hh);
#pragma unroll
            for (int r = 0; r < 16; ++r) { const float dd = dbase - (float)((r & 7) + 16 * (r >> 3)); a[r] = __builtin_fmaf(-slope, __builtin_fabsf(dd), a[r]); tmax = fmaxf(tmax, a[r]); }
            tmax = fmaxf(tmax, xor32f(tmax, hh != 0));
            const float mnew = fmaxf(mrun, tmax);
            const float alpha = fast_exp2(mrun - mnew);
            mrun = mnew;
            float psum = 0.f;
#pragma unroll
            for (int r = 0; r < 16; ++r) { const float p = fast_exp2(a[r] - mnew); a[r] = p; psum += p; }
            psum += xor32f(psum, hh != 0);
            lsum = lsum * alpha + psum;
#pragma unroll
            for (int r = 0; r < 16; ++r) { o0[r] *= alpha; o1[r] *= alpha; }
#pragma unroll
            for (int s = 0; s < 2; ++s) {
                u32x4 pw; pw.x = pg8::cvt_pk_bf16(a[8 * s + 0], a[8 * s + 1]); pw.y = pg8::cvt_pk_bf16(a[8 * s + 2], a[8 * s + 3]);
                pw.z = pg8::cvt_pk_bf16(a[8 * s + 4], a[8 * s + 5]); pw.w = pg8::cvt_pk_bf16(a[8 * s + 6], a[8 * s + 7]);
                const bf16x8 pf = __builtin_bit_cast(bf16x8, pw);
                const int kcol = (tt * 32 + s * 16 + hh * 8) * 2;
                const bf16x8 v0 = *(const LAS bf16x8*)(Vt + l31 * SWA_VT_STRIDE + kcol);
                const bf16x8 v1 = *(const LAS bf16x8*)(Vt + (32 + l31) * SWA_VT_STRIDE + kcol);
                o0 = __builtin_amdgcn_mfma_f32_32x32x16_bf16(v0, pf, o0, 0, 0, 0);
                o1 = __builtin_amdgcn_mfma_f32_32x32x16_bf16(v1, pf, o1, 0, 0, 0);
            }
        }
        const float inv = 1.0f / lsum;
        bf16* yp = Y + tok * 1024 + head * 64 + 4 * hh;
#pragma unroll
        for (int gq = 0; gq < 4; ++gq) {
            u32x2 w; w.x = pg8::cvt_pk_bf16(o0[4 * gq] * inv, o0[4 * gq + 1] * inv); w.y = pg8::cvt_pk_bf16(o0[4 * gq + 2] * inv, o0[4 * gq + 3] * inv);
            *(u32x2*)(yp + 8 * gq) = w;
            u32x2 w1; w1.x = pg8::cvt_pk_bf16(o1[4 * gq] * inv, o1[4 * gq + 1] * inv); w1.y = pg8::cvt_pk_bf16(o1[4 * gq + 2] * inv, o1[4 * gq + 3] * inv);
            *(u32x2*)(yp + 32 + 8 * gq) = w1;
        }
    }
#undef SWA_GLOAD
    __syncthreads();
}

constexpr int SB_KS = 144, SB_VS = 80, SB_LDS_WAVE = 32 * SB_KS + 64 * SB_VS;
__device__ __forceinline__ void sb_gload(u32x4 (&kr)[4], u32x4 (&vr)[4], const bf16* kg, const bf16* vg, int kt) {
#pragma unroll
    for (int j = 0; j < 4; ++j) kr[j] = *(const u32x4*)(kg + ((size_t)kt * 32 + j * 8) * 512);
#pragma unroll
    for (int j = 0; j < 4; ++j) vr[j] = *(const u32x4*)(vg + (size_t)j * 16 * MTOK + kt * 32);
}
__device__ __forceinline__ void sb_stage(LAS unsigned char* Kl, LAS unsigned char* Vl, const u32x4 (&kr)[4], const u32x4 (&vr)[4], int lane) {
#pragma unroll
    for (int j = 0; j < 4; ++j) *(LAS u32x4*)(Kl + (j * 8 + (lane >> 3)) * SB_KS + (lane & 7) * 16) = kr[j];
#pragma unroll
    for (int j = 0; j < 4; ++j) *(LAS u32x4*)(Vl + (j * 16 + (lane >> 2)) * SB_VS + (lane & 3) * 16) = vr[j];
}
__device__ __forceinline__ void sb_frag(bf16x8 (&kf)[4], bf16x8 (&vf)[2][2], const LAS unsigned char* Kl, const LAS unsigned char* Vl, int l31, int hh) {
#pragma unroll
    for (int ks = 0; ks < 4; ++ks) kf[ks] = *(const LAS bf16x8*)(Kl + pi32(l31) * SB_KS + hh * 64 + ks * 16);
#pragma unroll
    for (int dt = 0; dt < 2; ++dt)
#pragma unroll
        for (int sx = 0; sx < 2; ++sx) vf[dt][sx] = *(const LAS bf16x8*)(Vl + (dt * 32 + l31) * SB_VS + sx * 32 + hh * 16);
}
template <bool DIAG>
__device__ __forceinline__ bool sb_tile(const bf16x8 (&kf)[4], const bf16x8 (&vf)[2][2], const bf16x8 (&qf)[4], f32x16& o0, f32x16& o1, float& carry, int kt, int tq, int hh) {
    f32x16 a = {0.f, 0.f, 0.f, 0.f, 0.f, 0.f, 0.f, 0.f, 0.f, 0.f, 0.f, 0.f, 0.f, 0.f, 0.f, 0.f};
#pragma unroll
    for (int ks = 0; ks < 4; ++ks) a = __builtin_amdgcn_mfma_f32_32x32x16_bf16(kf[ks], qf[ks], a, 0, 0, 0);
    float L[16];
    const int kb0 = kt * 32 + 8 * hh;
    typedef float f2_t __attribute__((ext_vector_type(2)));
#pragma unroll
    for (int rp = 0; rp < 8; ++rp) { const int r0 = 2 * rp, r1 = r0 + 1; const float y0 = a[r0], y1 = a[r1];
        const f2_t t = {fast_exp2(-fabsf(y0)), fast_exp2(-fabsf(y1))};
        f2_t pl = t * 0.05994558706879616f + (-0.22771264612674713f); pl = pl * t + 0.44227418303489685f; pl = pl * t + (-0.7170639038085938f); pl = pl * t + 1.4426156282424927f; pl = pl * t;
        const f2_t mx = {__builtin_amdgcn_fmed3f(y0, 0.f, 3.0e38f), __builtin_amdgcn_fmed3f(y1, 0.f, 3.0e38f)};
        const f2_t sp = mx + pl;
        const int key0 = kb0 + (r0 & 7) + 16 * (r0 >> 3), key1 = kb0 + (r1 & 7) + 16 * (r1 >> 3);
        L[r0] = (!DIAG || key0 < tq) ? -sp.x : 0.f; L[r1] = (!DIAG || key1 < tq) ? -sp.y : 0.f; }
#pragma unroll
    for (int r = 6; r >= 0; --r) { L[r] += L[r + 1]; L[8 + r] += L[8 + r + 1]; }
    const float sA = L[0], sB = L[8];
    const float pA = xor32f(sA, hh != 0), pB = xor32f(sB, hh != 0);
    const float offA = (hh == 0) ? (pA + sB + pB) : (pB + sB);
    const float offB = (hh == 0) ? pB : 0.f;
    const float cA = offA + carry, cB = offB + carry;
    float p[16];
#pragma unroll
    for (int rp = 0; rp < 8; ++rp) { const int r0 = 2 * rp, r1 = r0 + 1; const float cc_ = rp < 4 ? cA : cB;
        const f2_t av = {a[r0], a[r1]}, lv = {L[r0], L[r1]}, cv = {cc_, cc_}; const f2_t e = (av + lv) + cv;
        const int key0 = kb0 + (r0 & 7) + 16 * (r0 >> 3), key1 = kb0 + (r1 & 7) + 16 * (r1 >> 3);
        p[r0] = (!DIAG || key0 < tq) ? fast_exp2(e.x) : 0.f; p[r1] = (!DIAG || key1 < tq) ? fast_exp2(e.y) : 0.f; }
    carry += sA + sB + pA + pB;
#pragma unroll
    for (int s = 0; s < 2; ++s) {
        u32x4 pw; pw.x = pg8::cvt_pk_bf16(p[8 * s + 0], p[8 * s + 1]); pw.y = pg8::cvt_pk_bf16(p[8 * s + 2], p[8 * s + 3]);
        pw.z = pg8::cvt_pk_bf16(p[8 * s + 4], p[8 * s + 5]); pw.w = pg8::cvt_pk_bf16(p[8 * s + 6], p[8 * s + 7]);
        const bf16x8 pf = __builtin_bit_cast(bf16x8, pw);
        o0 = __builtin_amdgcn_mfma_f32_32x32x16_bf16(vf[0][s], pf, o0, 0, 0, 0);
        o1 = __builtin_amdgcn_mfma_f32_32x32x16_bf16(vf[1][s], pf, o1, 0, 0, 0);
    }
    return __all(carry < SB_EXIT);
}
__device__ __forceinline__ void sb_phase(Ctx& F) {
    unsigned char* ws = F.ws;
    const bf16* QB = (const bf16*)(ws + WS_QB); const bf16* KB = (const bf16*)(ws + WS_KB); const bf16* VBT = (const bf16*)(ws + WS_VBT);
    bf16* Y = (bf16*)(ws + WS_H);
    const int lane = F.lane, l31 = lane & 31, hh = lane >> 5;
    const int gw = F.bid * 8 + F.wave, NGW = F.G * 8;
    LAS unsigned char* Kl = F.lds + F.wave * SB_LDS_WAVE; LAS unsigned char* Vl = Kl + 32 * SB_KS;
#define SB_ITEM(it_, qt_, hd_, b_, tq_, tok_, kg_, vg_) const int qt_ = 63 - ((it_) & 63), hd_ = ((it_) >> 6) & 7, b_ = (it_) >> 9; const int tq_ = qt_ * 32 + l31; \
        const size_t tok_ = (size_t)b_ * SEQ + tq_; const bf16* kg_ = KB + ((size_t)b_ * SEQ + (lane >> 3)) * 512 + hd_ * 64 + (lane & 7) * 8; const bf16* vg_ = VBT + (size_t)(hd_ * 64 + (lane >> 2)) * MTOK + (size_t)b_ * SEQ + (lane & 3) * 8
    const int nitems = BATCH * 8 * 64;
    const bool xmap = (F.G == 256) && (nitems == 256 * 64);
    const int xcd = F.bid & 7, widx = F.bid >> 3;
#define SB_SEQ(k_) (xmap ? (((xcd + 8 * ((k_) * 4 + (widx >> 3))) * 64) + (widx & 7) * 8 + F.wave) : (gw + (k_) * NGW))
    const int nseq = xmap ? 8 : (nitems - gw + NGW - 1) / NGW;
    bf16x8 qn[4]; u32x4 kn[4], vn[4];
    if (nseq > 0) { SB_ITEM(SB_SEQ(0), qt0, hd0, b0, tq0, tok0, kg0, vg0); const u32x4* qp = (const u32x4*)(QB + tok0 * 512 + hd0 * 64 + hh * 32);
#pragma unroll
        for (int j = 0; j < 4; ++j) qn[j] = __builtin_bit_cast(bf16x8, qp[j]);
        sb_gload(kn, vn, kg0, vg0, qt0); (void)tq0;
        unsigned char* dmy = ws + WS_H8 + ((size_t)gw * 64 + lane) * 8;
#pragma unroll
        for (int i = 0; i < 8; ++i) *(u32x2*)(dmy + (size_t)i * (2 * MiB)) = (u32x2){0u, 0u}; }
    for (int sq = 0; sq < nseq; ++sq) {
        const int item = SB_SEQ(sq);
        SB_ITEM(item, qt, hd, b, tq, tok, kg, vg);
        bf16x8 qf[4], kf[4], vf[2][2]; u32x4 kx[4], vx[4];
#pragma unroll
        for (int j = 0; j < 4; ++j) qf[j] = qn[j];
        asm volatile("" ::: "memory");
        sb_stage(Kl, Vl, kn, vn, lane);
        asm volatile("" ::: "memory");
        { const int nitem = (sq + 1 < nseq) ? SB_SEQ(sq + 1) : item; SB_ITEM(nitem, qtn, hdn, bn, tqn, tokn, kgn, vgn); const u32x4* qp = (const u32x4*)(QB + tokn * 512 + hdn * 64 + hh * 32);
#pragma unroll
          for (int j = 0; j < 4; ++j) qn[j] = __builtin_bit_cast(bf16x8, qp[j]);
          sb_gload(kn, vn, kgn, vgn, qtn); (void)tqn; }
        f32x16 o0 = {0.f, 0.f, 0.f, 0.f, 0.f, 0.f, 0.f, 0.f, 0.f, 0.f, 0.f, 0.f, 0.f, 0.f, 0.f, 0.f}, o1 = o0;
        float carry = 0.f;
        {
            int kt = qt;
            sb_gload(kx, vx, kg, vg, kt > 0 ? kt - 1 : 0);
            asm volatile("" ::: "memory");
            sb_frag(kf, vf, Kl, Vl, l31, hh);
            asm volatile("" ::: "memory");
            __builtin_amdgcn_sched_barrier(0);
            if (!(sb_tile<true>(kf, vf, qf, o0, o1, carry, kt, tq, hh) || kt == 0)) {
                --kt;
                for (;;) {
                    sb_stage(Kl, Vl, kx, vx, lane);
                    asm volatile("" ::: "memory");
                    __builtin_amdgcn_sched_barrier(0);
                    sb_gload(kx, vx, kg, vg, kt > 0 ? kt - 1 : 0);
                    sb_frag(kf, vf, Kl, Vl, l31, hh);
                    asm volatile("" ::: "memory");
                    __builtin_amdgcn_sched_barrier(0);
                    if (sb_tile<false>(kf, vf, qf, o0, o1, carry, kt, tq, hh) || kt == 0) break;
                    --kt;
                }
            }
        }
        bf16* yp = Y + tok * 1024 + 512 + hd * 64 + 4 * hh;
#pragma unroll
        for (int gq = 0; gq < 4; ++gq) {
            u32x2 w; w.x = pg8::cvt_pk_bf16(o0[4 * gq], o0[4 * gq + 1]); w.y = pg8::cvt_pk_bf16(o0[4 * gq + 2], o0[4 * gq + 3]);
            *(u32x2*)(yp + 8 * gq) = w;
            u32x2 w1; w1.x = pg8::cvt_pk_bf16(o1[4 * gq], o1[4 * gq + 1]); w1.y = pg8::cvt_pk_bf16(o1[4 * gq + 2], o1[4 * gq + 3]);
            *(u32x2*)(yp + 32 + 8 * gq) = w1;
        }
    }
#undef SB_ITEM
#undef SB_SEQ
}

#define P6_IDX(T, off_) do { _Pragma("unroll") for (int i = 0; i < 4; ++i) { const unsigned w = (127u - (T[4 * i] & 127u)) | ((127u - (T[4 * i + 1] & 127u)) << 8) | ((127u - (T[4 * i + 2] & 127u)) << 16) | ((127u - (T[4 * i + 3] & 127u)) << 24); \
        *(LAS unsigned*)(idxl + (off_) + lane * 16 + i * 4) = w; } } while (0)
__device__ __forceinline__ int lane_id() { return (int)__builtin_amdgcn_mbcnt_hi(~0u, __builtin_amdgcn_mbcnt_lo(~0u, 0u)); }
__device__ __forceinline__ void peer_select_phase(Ctx& F) {
    unsigned char* ws = F.ws;
    const unsigned* L1K = (const unsigned*)(ws + WS_GATES);
    const bf16* X1B = (const bf16*)(ws + WS_H); const float* SSQ = (const float*)(ws + WS_SSQ);
    unsigned short* PE = (unsigned short*)(ws + WS_PE); float* PG = (float*)(ws + WS_PG); float* SXR = (float*)(ws + WS_SXR); float* RSTD = (float*)(ws + WS_RSTD);
    const int lane = lane_id(), wave = F.wave;
    LAS unsigned char* idxl = F.lds + wave * 2048;
    const int gw = F.bid * 8 + F.wave, NGW = F.G * 8, NGRP = MTOK / 8;
    const int tl = lane >> 4, list = lane & 15, p = lane & 1, head = list >> 1;
#define P6_LOADT(TQ, tok_) do { const u32x4* sp_ = (const u32x4*)(L1K + ((size_t)(tok_) * 16 + list) * 16); TQ[0] = sp_[0]; TQ[1] = sp_[1]; TQ[2] = sp_[2]; TQ[3] = sp_[3]; } while (0)
    u32x4 tqA[4], tqB[4];
    if (gw < NGRP) { P6_LOADT(tqA, gw * 8 + tl); P6_LOADT(tqB, gw * 8 + 4 + tl); }
    for (int grp = gw; grp < NGRP; grp += NGW) {
        const int t0 = grp * 8, tokL = t0 + 4 * p + tl;
        unsigned TA[16], TB[16];
#pragma unroll
        for (int i = 0; i < 4; ++i) { TA[4 * i] = tqA[i].x; TA[4 * i + 1] = tqA[i].y; TA[4 * i + 2] = tqA[i].z; TA[4 * i + 3] = tqA[i].w; TB[4 * i] = tqB[i].x; TB[4 * i + 1] = tqB[i].y; TB[4 * i + 2] = tqB[i].z; TB[4 * i + 3] = tqB[i].w; }
        { const int gn = (grp + NGW < NGRP) ? grp + NGW : grp; P6_LOADT(tqA, gn * 8 + tl); P6_LOADT(tqB, gn * 8 + 4 + tl); }
        P6_IDX(TA, 0);
        P6_IDX(TB, 1024);
        __builtin_amdgcn_sched_barrier(0);
        f32x4 sq0, sq1, sq2, sq3;
        { const f32x4* sp = (const f32x4*)(SSQ + (size_t)tokL * 16); sq0 = sp[0]; sq1 = sp[1]; sq2 = sp[2]; sq3 = sp[3]; }
        __builtin_amdgcn_sched_barrier(0);
        float va[16], vb[16];
#pragma unroll
        for (int i = 0; i < 16; ++i) { const unsigned send = p ? TA[i] : TB[i]; const unsigned recv = (unsigned)__builtin_amdgcn_update_dpp(0, (int)send, 0xB1, 0xf, 0xf, true);
            const unsigned ka = p ? recv : TA[i], kb = p ? TB[i] : recv;
            va[i] = unord16(ka >> 16); vb[i] = unord16(kb >> 16); }
#define CAND(i, j) ((ord32(va[i] + vb[j]) & 0xffffff00u) | (unsigned)(255 - ((i) * 16 + (j))))
        unsigned R[16];
#pragma unroll
        for (int j = 0; j < 16; ++j) R[j] = CAND(0, j);
        { unsigned C[16];
#pragma unroll
          for (int j = 0; j < 8; ++j) C[j] = CAND(1, j);
#pragma unroll
          for (int j = 0; j < 5; ++j) C[8 + j] = CAND(2, j);
#pragma unroll
          for (int j = 0; j < 3; ++j) C[13 + j] = CAND(4, j);
          SORT16(C); MERGE16(R, C);
#pragma unroll
          for (int j = 0; j < 4; ++j) C[j] = CAND(3, j);
          C[4] = CAND(5, 0); C[5] = CAND(5, 1); C[6] = CAND(6, 0); C[7] = CAND(6, 1); C[8] = CAND(7, 0); C[9] = CAND(7, 1);
          C[10] = CAND(8, 0); C[11] = CAND(9, 0); C[12] = CAND(10, 0); C[13] = CAND(11, 0); C[14] = CAND(12, 0); C[15] = CAND(13, 0);
          SORT16(C); MERGE16(R, C);
          unsigned x14 = CAND(14, 0); INS16(R, x14); unsigned x15 = CAND(15, 0); INS16(R, x15); }
#undef CAND
        __builtin_amdgcn_sched_barrier(0);
        __builtin_amdgcn_sched_barrier(0);
        const float ssq = ((sq0.x + sq0.y) + (sq0.z + sq0.w)) + ((sq1.x + sq1.y) + (sq1.z + sq1.w)) + ((sq2.x + sq2.y) + (sq2.z + sq2.w)) + ((sq3.x + sq3.y) + (sq3.z + sq3.w));
        const float rms = 1.0f / sqrtf(ssq * (1.f / D) + RMS_EPS);
        {
            const float s0 = unord32(R[0] & 0xffffff00u);
            float gsum = 0.f; float gv[16];
#pragma unroll
            for (int k = 0; k < 16; ++k) { gv[k] = fast_exp2((unord32(R[k] & 0xffffff00u) - s0) * rms * LOG2E); gsum += gv[k]; }
            const float ginv = 1.0f / gsum;
            LAS const unsigned char* la = idxl + p * 1024 + (lane & ~1) * 16; LAS const unsigned char* lb = idxl + p * 1024 + (lane | 1) * 16;
            unsigned ex[16];
#pragma unroll
            for (int k = 0; k < 16; ++k) { const int pos = 255 - (int)(R[k] & 255u); ex[k] = (unsigned)la[pos >> 4] * 128u + (unsigned)lb[pos & 15]; }
            u32x4* pe = (u32x4*)(PE + (size_t)tokL * 128 + head * 16); f32x4* pg = (f32x4*)(PG + (size_t)tokL * 128 + head * 16);
#pragma unroll
            for (int k = 0; k < 2; ++k) { u32x4 w; w.x = ex[8 * k] | (ex[8 * k + 1] << 16); w.y = ex[8 * k + 2] | (ex[8 * k + 3] << 16); w.z = ex[8 * k + 4] | (ex[8 * k + 5] << 16); w.w = ex[8 * k + 6] | (ex[8 * k + 7] << 16); pe[k] = w; }
#pragma unroll
            for (int k = 0; k < 4; ++k) { f32x4 g; g.x = gv[4 * k] * ginv; g.y = gv[4 * k + 1] * ginv; g.z = gv[4 * k + 2] * ginv; g.w = gv[4 * k + 3] * ginv; pg[k] = g; }
        }
        if ((lane & 14) == 0) { RSTD[tokL] = rms; SXR[tokL] = 8.f / 127.f; }
    }
}

#define PA_LOAD_META(ID, XC, RS, tk) do { ID = PE[(size_t)(tk) * 64 + lane]; XC = *(const unsigned*)((const unsigned char*)X1B + (size_t)(tk) * 2048 + x * 256 + lane * 4); RS = RSTD[(size_t)(tk) + vzero]; } while (0)
#define PX_BC8(dst_, src_, qp_, lo_) do { const int q_ = __builtin_amdgcn_update_dpp(0, (int)(src_), qp_, 0xf, 0xf, true); \
        dst_ = (lo_) ? (unsigned)__builtin_amdgcn_update_dpp(q_, q_, 0x114, 0xf, 0xa, false) : (unsigned)__builtin_amdgcn_update_dpp(q_, q_, 0x104, 0xf, 0x5, false); } while (0)
#define PA_ISSUE2(R, ID, k_, qp_, lo_) do { unsigned w_; PX_BC8(w_, ID, qp_, lo_); \
        R[2 * (k_)] = *(const u32x4*)(tabu + ((w_ & 0xffffu) * 128u + coff)); R[2 * (k_) + 1] = *(const u32x4*)(tabu + ((w_ >> 16) * 128u + coff)); } while (0)
#define PA_ISSUE(R, ID) do { PA_ISSUE2(R, ID, 0, 0x00, true); PA_ISSUE2(R, ID, 1, 0x55, true); PA_ISSUE2(R, ID, 2, 0xAA, true); PA_ISSUE2(R, ID, 3, 0xFF, true); \
        PA_ISSUE2(R, ID, 4, 0x00, false); PA_ISSUE2(R, ID, 5, 0x55, false); PA_ISSUE2(R, ID, 6, 0xAA, false); PA_ISSUE2(R, ID, 7, 0xFF, false); } while (0)
#define PA_XS(XS, XC, RS) do { const float s_ = (RS) * (127.f / 8.f); \
        const int q0_ = (int)rintf(__builtin_amdgcn_fmed3f(bflo(XC) * s_, -127.f, 127.f)), q1_ = (int)rintf(__builtin_amdgcn_fmed3f(bfhi(XC) * s_, -127.f, 127.f)); \
        const unsigned pk_ = (unsigned)(q0_ & 255) | ((unsigned)(q1_ & 255) << 8); const unsigned pt_ = (unsigned)__builtin_amdgcn_update_dpp(0, (int)pk_, 0xB1, 0xf, 0xf, true); \
        const unsigned w_ = (lane & 1) ? (pt_ | (pk_ << 16)) : (pk_ | (pt_ << 16)); \
        XS.x = (unsigned)__builtin_amdgcn_ds_bpermute(c * 32, (int)w_); XS.y = (unsigned)__builtin_amdgcn_ds_bpermute(c * 32 + 8, (int)w_); \
        XS.z = (unsigned)__builtin_amdgcn_ds_bpermute(c * 32 + 16, (int)w_); XS.w = (unsigned)__builtin_amdgcn_ds_bpermute(c * 32 + 24, (int)w_); } while (0)
#define PA_DOT(d, R, XS) do { \
        _Pragma("unroll") for (int i = 0; i < 16; ++i) { const u32x4 u = R[i]; \
            int a = __builtin_amdgcn_sdot4((int)u.x, (int)XS.x, 0, false); a = __builtin_amdgcn_sdot4((int)u.y, (int)XS.y, a, false); \
            a = __builtin_amdgcn_sdot4((int)u.z, (int)XS.z, a, false); a = __builtin_amdgcn_sdot4((int)u.w, (int)XS.w, a, false); d[i] = a; } } while (0)
#define PA_REDUCE_STORE(d, tk) do { \
        _Pragma("unroll") for (int i = 0; i < 8; ++i) { const int a = d[i], b = d[i + 8]; const int R_ = (lane & 4) ? b : a, S_ = (lane & 4) ? a : b; \
            d[i] = R_ + (int)__builtin_amdgcn_update_dpp(0u, (unsigned)S_, 0x141, 0xf, 0xf, true); } \
        _Pragma("unroll") for (int i = 0; i < 4; ++i) { const int a = d[i], b = d[i + 4]; const int R_ = (lane & 2) ? b : a, S_ = (lane & 2) ? a : b; \
            d[i] = R_ + (int)__builtin_amdgcn_update_dpp(0u, (unsigned)S_, 0x4E, 0xf, 0xf, true); } \
        _Pragma("unroll") for (int i = 0; i < 2; ++i) { const int a = d[i], b = d[i + 2]; const int R_ = (lane & 1) ? b : a, S_ = (lane & 1) ? a : b; \
            d[i] = R_ + (int)__builtin_amdgcn_update_dpp(0u, (unsigned)S_, 0xB1, 0xf, 0xf, true); } \
          \
        ((unsigned*)PD)[((size_t)x * MTOK + (tk)) * 64 + lane] = (unsigned)(((d[0] + 32) >> 6) & 0xffff) | ((unsigned)((d[1] + 32) >> 6) << 16); } while (0)
__device__ __forceinline__ void peer_dot_phase(Ctx& F, size_t tab_off = WS_UT, size_t pd_off = WS_PD) {
    unsigned char* ws = F.ws;
    const unsigned char* UT8 = ws + tab_off; const bf16* X1B = (const bf16*)(ws + WS_H); const float* RSTD = (const float*)(ws + WS_RSTD); const unsigned* PE = (const unsigned*)(ws + WS_PE); int* PD = (int*)(ws + pd_off);
    const int lane = lane_id(), g = lane >> 3, c = lane & 7;
    int vzero; asm volatile("v_mov_b32 %0, 0" : "=v"(vzero));

    const int x = F.bid & 7, wq = (F.bid >> 3) * 8 + F.wave, nwq = (F.G >> 3) * 8;
    const unsigned char* tabu = UT8 + (size_t)x * NEXP * 128; const unsigned coff = (unsigned)c * 16u;
    const int cnt = (MTOK - wq + nwq - 1) / nwq;
    if (cnt <= 0) return;
#define TOKN(n) (wq + ((n) < cnt ? (n) : cnt - 1) * nwq)
    const int bpa = (lane & ~7) * 4;
    unsigned idA, idB; u32x4 rA[16], rB[16], xsA, xsB; unsigned xcA, xcB; float rsA, rsB;
    PA_LOAD_META(idA, xcA, rsA, TOKN(0)); PA_LOAD_META(idB, xcB, rsB, TOKN(1)); PA_ISSUE(rA, idA); PA_ISSUE(rB, idB); PA_XS(xsA, xcA, rsA); PA_XS(xsB, xcB, rsB);
    PA_LOAD_META(idA, xcA, rsA, TOKN(2)); PA_LOAD_META(idB, xcB, rsB, TOKN(3));
#define PA_STEP(R, XS, ID, XC, RS, n_, guard) do { int d[16]; PA_DOT(d, R, XS); \
        __builtin_amdgcn_sched_barrier(0); \
        PA_ISSUE(R, ID); PA_XS(XS, XC, RS); PA_LOAD_META(ID, XC, RS, TOKN((n_) + 4)); \
        __builtin_amdgcn_sched_barrier(0); \
        if (guard) PA_REDUCE_STORE(d, TOKN(n_)); \
        __builtin_amdgcn_sched_barrier(0); } while (0)
    int n = 0;
    for (; n + 8 <= cnt; n += 8) {
        PA_STEP(rA, xsA, idA, xcA, rsA, n, true); PA_STEP(rB, xsB, idB, xcB, rsB, n + 1, true); PA_STEP(rA, xsA, idA, xcA, rsA, n + 2, true); PA_STEP(rB, xsB, idB, xcB, rsB, n + 3, true);
        PA_STEP(rA, xsA, idA, xcA, rsA, n + 4, true); PA_STEP(rB, xsB, idB, xcB, rsB, n + 5, true); PA_STEP(rA, xsA, idA, xcA, rsA, n + 6, true); PA_STEP(rB, xsB, idB, xcB, rsB, n + 7, true);
    }
    for (; n < cnt; n += 2) { PA_STEP(rA, xsA, idA, xcA, rsA, n, true); PA_STEP(rB, xsB, idB, xcB, rsB, n + 1, n + 1 < cnt); }
#undef PA_STEP
#undef TOKN
}

__device__ __forceinline__ void peer_coef_phase(Ctx& F) {
    unsigned char* ws = F.ws;
    const unsigned* PD = (const unsigned*)(ws + WS_PD); const unsigned* PE = (const unsigned*)(ws + WS_PE); const float* PG = (const float*)(ws + WS_PG);
    const float* SU = (const float*)(ws + WS_SU); const float* SV = (const float*)(ws + WS_SV); const float* SXR = (const float*)(ws + WS_SXR);
    unsigned short* PC8 = (unsigned short*)(ws + WS_PC); float* SCT = (float*)(ws + WS_SCT);
    const int gw = F.bid * 8 + F.wave, NGW = F.G * 8, lane = lane_id();
    for (int b = gw; b < MTOK / 8; b += NGW) {
        const int t0 = b * 8;
        unsigned pd[8][8], ev[8]; f32x2 gv[8]; float sxr[8];
#pragma unroll
        for (int j = 0; j < 8; ++j) ev[j] = PE[(size_t)(t0 + j) * 64 + lane];
        __builtin_amdgcn_sched_barrier(0);
#pragma unroll
        for (int j = 0; j < 8; ++j) {
#pragma unroll
            for (int x = 0; x < 8; ++x) pd[j][x] = PD[((size_t)x * MTOK + t0 + j) * 64 + lane];
            gv[j] = *(const f32x2*)(PG + (size_t)(t0 + j) * 128 + 2 * lane); sxr[j] = SXR[t0 + j];
        }
        __builtin_amdgcn_sched_barrier(0);
        float su0[8], su1[8], sv0[8], sv1[8];
#pragma unroll
        for (int j = 0; j < 8; ++j) { const unsigned e0 = ev[j] & 0xffffu, e1 = ev[j] >> 16; su0[j] = SU[e0]; su1[j] = SU[e1]; sv0[j] = SV[e0]; sv1[j] = SV[e1]; }
        __builtin_amdgcn_sched_barrier(0);
#pragma unroll
        for (int j = 0; j < 8; ++j) {
            int s0 = 0, s1 = 0;
#pragma unroll
            for (int x = 0; x < 8; ++x) { const unsigned v = pd[j][x]; s0 += (int)(short)(v & 0xffffu); s1 += (int)v >> 16; }
            s0 <<= 6; s1 <<= 6;
            const float c0 = gv[j].x * gelu_erf((float)s0 * su0[j] * sxr[j]) * sv0[j], c1 = gv[j].y * gelu_erf((float)s1 * su1[j] * sxr[j]) * sv1[j];
            float m = fmaxf(fabsf(c0), fabsf(c1));
#pragma unroll
            for (int o = 1; o < 64; o <<= 1) m = fmaxf(m, __shfl_xor(m, o));
            const float sc = m > 0.f ? m * (1.f / 127.f) : 1.f, ic = 1.f / sc;
            const int q0 = (int)rintf(c0 * ic), q1 = (int)rintf(c1 * ic);
            PC8[(size_t)(t0 + j) * 64 + lane] = (unsigned short)((q0 & 255) | ((q1 & 255) << 8));
            if (lane == 0) SCT[t0 + j] = sc;
        }
    }
}

#define PB_LOAD_ID(ID, tk) do { ID = PE[(size_t)(tk) * 64 + lane]; } while (0)
#define PB_LOAD_CC(CC, XD, tk) do { CC = *((lane < 32) ? (const unsigned*)(PC8 + (size_t)(tk) * 128 + lane * 4) : (const unsigned*)(SCT + (tk))); \
        XD = *(const unsigned*)((const unsigned char*)X1B + (size_t)(tk) * 2048 + x * 256 + xdo); } while (0)
#define PB_BC8(dst_, src_, qp_, lo_) do { const int q_ = __builtin_amdgcn_update_dpp(0, (int)(src_), qp_, 0xf, 0xf, true); \
        dst_ = (lo_) ? (unsigned)__builtin_amdgcn_update_dpp(q_, q_, 0x114, 0xf, 0xa, false) : (unsigned)__builtin_amdgcn_update_dpp(q_, q_, 0x104, 0xf, 0x5, false); } while (0)
#define PB_ISSUE2(R, ID, k_, qp_, lo_) do { unsigned w_; PB_BC8(w_, ID, qp_, lo_); \
        R[2 * (k_)] = *(const u32x4*)(tabu + ((w_ & 0xffffu) * 128u + coff)); R[2 * (k_) + 1] = *(const u32x4*)(tabu + ((w_ >> 16) * 128u + coff)); } while (0)
#define PB_ISSUE(R, ID) do { PB_ISSUE2(R, ID, 0, 0x00, true); PB_ISSUE2(R, ID, 1, 0x55, true); PB_ISSUE2(R, ID, 2, 0xAA, true); PB_ISSUE2(R, ID, 3, 0xFF, true); \
        PB_ISSUE2(R, ID, 4, 0x00, false); PB_ISSUE2(R, ID, 5, 0x55, false); PB_ISSUE2(R, ID, 6, 0xAA, false); PB_ISSUE2(R, ID, 7, 0xFF, false); } while (0)
#define PB_BLK(R, q_, CQ) do { _Pragma("unroll") for (int j_ = 0; j_ < 4; ++j_) { const unsigned a0_ = R[4 * (q_)][j_], a1_ = R[4 * (q_) + 1][j_], a2_ = R[4 * (q_) + 2][j_], a3_ = R[4 * (q_) + 3][j_]; \
            const unsigned l01_ = __builtin_amdgcn_perm(a1_, a0_, 0x05010400u), h01_ = __builtin_amdgcn_perm(a1_, a0_, 0x07030602u), l23_ = __builtin_amdgcn_perm(a3_, a2_, 0x05010400u), h23_ = __builtin_amdgcn_perm(a3_, a2_, 0x07030602u); \
            acc[4 * j_]     = __builtin_amdgcn_sdot4((int)__builtin_amdgcn_perm(l23_, l01_, 0x05040100u), (int)(CQ), acc[4 * j_], false); \
            acc[4 * j_ + 1] = __builtin_amdgcn_sdot4((int)__builtin_amdgcn_perm(l23_, l01_, 0x07060302u), (int)(CQ), acc[4 * j_ + 1], false); \
            acc[4 * j_ + 2] = __builtin_amdgcn_sdot4((int)__builtin_amdgcn_perm(h23_, h01_, 0x05040100u), (int)(CQ), acc[4 * j_ + 2], false); \
            acc[4 * j_ + 3] = __builtin_amdgcn_sdot4((int)__builtin_amdgcn_perm(h23_, h01_, 0x07060302u), (int)(CQ), acc[4 * j_ + 3], false); } } while (0)
__device__ __forceinline__ void peer_axpy_phase(Ctx& F) {
    unsigned char* ws = F.ws;
    const unsigned char* VT8 = ws + WS_VT; const unsigned* PE = (const unsigned*)(ws + WS_PE); const unsigned char* PC8 = ws + WS_PC; const float* SCT = (const float*)(ws + WS_SCT);
    const bf16* X1B = (const bf16*)(ws + WS_H);
    const int lane = lane_id(), g = lane >> 3, c = lane & 7;
    const int x = F.bid & 7, wq = (F.bid >> 3) * 8 + F.wave, nwq = (F.G >> 3) * 8;
    const unsigned char* tabu = VT8 + (size_t)x * NEXP * 128; const unsigned coff = (unsigned)c * 16u;
    LAS unsigned char* wsm = F.lds + F.wave * 256;
    const int k0 = ((lane >> 3) & 1) * 8 + ((lane >> 4) & 1) * 4 + ((lane >> 5) & 1) * 2;
    const unsigned xdo = (unsigned)((16 * c + k0) * 2);
    const size_t ochan = (size_t)(x * 128 + 16 * c + k0);
    const bool b3 = (lane & 8) != 0;
    const int cnt = (MTOK - wq + nwq - 1) / nwq;
    if (cnt <= 0) return;
#define TOKN(n) (wq + ((n) < cnt ? (n) : cnt - 1) * nwq)
    unsigned idA, idB; u32x4 rA[16], rB[16]; unsigned ccA, ccB, xdA, xdB;
    PB_LOAD_ID(idA, TOKN(0)); PB_LOAD_ID(idB, TOKN(1)); PB_LOAD_CC(ccA, xdA, TOKN(0)); PB_LOAD_CC(ccB, xdB, TOKN(1)); PB_ISSUE(rA, idA); PB_ISSUE(rB, idB);
    PB_LOAD_ID(idA, TOKN(2)); PB_LOAD_ID(idB, TOKN(3));
#define PB_STEP(R, ID, CC, XD, n_, guard) do { \
        const float sc_ = __builtin_bit_cast(float, __builtin_amdgcn_readlane((int)CC, 32)); const unsigned xr_ = XD; \
        *(LAS unsigned*)(wsm + lane * 4) = CC; const u32x4 cq_ = *(const LAS u32x4*)(wsm + g * 16); \
        int acc[16]; _Pragma("unroll") for (int i_ = 0; i_ < 16; ++i_) acc[i_] = 0; \
        PB_BLK(R, 0, cq_.x); PB_BLK(R, 1, cq_.y); PB_BLK(R, 2, cq_.z); PB_BLK(R, 3, cq_.w); \
        __builtin_amdgcn_sched_barrier(0); \
        PB_ISSUE(R, ID); PB_LOAD_ID(ID, TOKN((n_) + 4)); PB_LOAD_CC(CC, XD, TOKN((n_) + 2)); \
        __builtin_amdgcn_sched_barrier(0); \
        if (guard) { int v_[8], w_[4], z_[2]; \
            _Pragma("unroll") for (int i_ = 0; i_ < 8; ++i_) { const int keep_ = b3 ? acc[8 + i_] : acc[i_], send_ = b3 ? acc[i_] : acc[8 + i_]; v_[i_] = keep_ + __builtin_amdgcn_update_dpp(0, send_, 0x128, 0xf, 0xf, true); } \
            _Pragma("unroll") for (int i_ = 0; i_ < 4; ++i_) { auto r_ = __builtin_amdgcn_permlane16_swap((unsigned)v_[i_], (unsigned)v_[4 + i_], false, false); w_[i_] = (int)(r_[0] + r_[1]); } \
            _Pragma("unroll") for (int i_ = 0; i_ < 2; ++i_) { auto r_ = __builtin_amdgcn_permlane32_swap((unsigned)w_[i_], (unsigned)w_[2 + i_], false, false); z_[i_] = (int)(r_[0] + r_[1]); } \
            f32x2 o_; o_.x = bflo(xr_) + sc_ * (float)z_[0]; o_.y = bfhi(xr_) + sc_ * (float)z_[1]; \
            *(f32x2*)(F.out + (size_t)TOKN(n_) * D + ochan) = o_; } \
        __builtin_amdgcn_sched_barrier(0); } while (0)
#define PB_STEP_A(n_, guard) PB_STEP(rA, idA, ccA, xdA, n_, guard)
#define PB_STEP_B(n_, guard) PB_STEP(rB, idB, ccB, xdB, n_, guard)
    int n = 0;
    for (; n + 8 <= cnt; n += 8) { PB_STEP_A(n, true); PB_STEP_B(n + 1, true); PB_STEP_A(n + 2, true); PB_STEP_B(n + 3, true); PB_STEP_A(n + 4, true); PB_STEP_B(n + 5, true); PB_STEP_A(n + 6, true); PB_STEP_B(n + 7, true); }
    for (; n < cnt; n += 2) { PB_STEP_A(n, true); PB_STEP_B(n + 1, n + 1 < cnt); }
#undef PB_STEP
#undef PB_STEP_A
#undef PB_STEP_B
#undef TOKN
}

__global__ void __launch_bounds__(NTHR, 2) fwd_kernel(Args args) {
    extern __shared__ __attribute__((aligned(16))) unsigned char lds_raw[];
    Ctx F;
    F.lds = (LAS unsigned char*)lds_raw;
    F.tid = threadIdx.x; F.lane = F.tid & 63; F.wave = __builtin_amdgcn_readfirstlane(F.tid >> 6); F.G = gridDim.x; F.bid = blockIdx.x;
    F.x = args.in[0]; F.g1 = args.in[1]; F.w_in = args.in[2]; F.gate_bias = args.in[3]; F.qgain = args.in[4]; F.kgain = args.in[5]; F.sinks = args.in[6];
    F.w_up_a = args.in[7]; F.w_up_b = args.in[8]; F.w_out = args.in[9]; F.g2 = args.in[10]; F.w_q = args.in[11]; F.sub_keys = args.in[12]; F.pu = args.in[13]; F.pv = args.in[14];
    F.out = args.out; F.ws = args.ws;
    unsigned char* ws = args.ws;
    const int lo = args.ph_lo, hi = args.ph_hi;
    XcdBarrier xbar; xbar.bar = (unsigned*)ws; xbar.x = 0; xbar.st = nullptr;
    if (hi - lo > 1) {
        volatile LAS unsigned* st = (volatile LAS unsigned*)(F.lds + LDS_BYTES - 64);
        if (F.tid < 2) st[F.tid] = 0u;
        __syncthreads();
        xbar = xcd_barrier_post((unsigned*)ws, st);
    }
#ifdef ONLY_PHASE
#define IN(k) ((k) == ONLY_PHASE)
#else
#define IN(k) (lo <= (k) && (k) < hi)
#endif
#define SEAM(k) do { if (IN(k) && IN((k) + 1)) { xcd_barrier(xbar); } } while (0)
#define RUNP(k, ...) do { if (IN(k)) { __VA_ARGS__ if (REP_PHASE == (k)) { __VA_ARGS__ } } } while (0)
    RUNP(0, p0_prep(F););
    SEAM(0);
    RUNP(1,
        LAS float* gbl = (LAS float*)(F.lds + 131072);
        for (int i = F.tid; i < 2048; i += NTHR) gbl[i] = F.gate_bias[i];
        __syncthreads();
        { pg8::Gemm g{(const bf16*)(ws + WS_H), (const bf16*)(ws + WS_W1T), MTOK, 1024, D, D, D}; pg8::StaticOrder S; S.init(MTOK, 1024, F.G, F.bid);
          Epi1Map E{ws, gbl, 1.f, 1.f, 0, (3 << 16) | 3}; pg8::gemm_phase<Epi1Map, pg8::StaticOrder>(F.lds, g, S, E); }
        { pg8::Gemm g{(const bf16*)(ws + WS_H8), (const bf16*)(ws + WS_WG8T), MTOK, 2816, D / 2, D / 2, D / 2}; pg8::StaticOrder S; S.init(MTOK, 2816, F.G, F.bid);
          Epi1Map E{ws, gbl, 1.f / 64.f, 1.f / 64.f, 3, (4 << 16) | 0}; pg8::gemm_phase_fp8<Epi1Map, pg8::StaticOrder>(F.lds, g, S, E); }
        { pg8::Gemm g{(const bf16*)(ws + WS_WVBT), (const bf16*)(ws + WS_H), 512, MTOK, D, D, D}; pg8::StaticOrder S; S.init(512, MTOK, F.G, F.bid);
          EpiStore<false> E{(unsigned short*)(ws + WS_VBT), MTOK}; pg8::gemm_phase<EpiStore<false>, pg8::StaticOrder>(F.lds, g, S, E); }
    );
    SEAM(1);
    RUNP(2, swa_phase(F); if (REP_PHASE == 20) swa_phase(F); sb_phase(F); if (REP_PHASE == 21) sb_phase(F););
    SEAM(2);
    RUNP(3,
        { pg8::Gemm g{(const bf16*)(ws + WS_H), (const bf16*)(ws + WS_WUPT), MTOK, D, 512, D, D}; pg8::StaticOrder S; S.init(MTOK, D, F.G, F.bid);
          EpiUpChain E{ws + WS_GATES, ws + WS_M8}; pg8::gemm_phase<EpiUpChain, pg8::StaticOrder, true>(F.lds, g, S, E, 1024); }
    );
    SEAM(3);
    RUNP(4,
        { pg8::Gemm g{(const bf16*)(ws + WS_M8), (const bf16*)(ws + WS_WOUT8T), MTOK, D, D / 2, D / 2, D / 2}; pg8::StaticOrder S; S.init(MTOK, D, F.G, F.bid);
          EpiOut E{F.x, F.out, (bf16*)(ws + WS_H), (float*)(ws + WS_SSQ), 1.f / 64.f}; pg8::gemm_phase_fp8<EpiOut, pg8::StaticOrder>(F.lds, g, S, E); }
    );
    SEAM(4);
    RUNP(5,
        { pg8::Gemm g{(const bf16*)(ws + WS_H), (const bf16*)(ws + WS_WST), MTOK, 2048, D, D, D}; pg8::StaticOrder S; S.init(MTOK, 2048, F.G, F.bid, P5_WGM);
          EpiTopK E{F.lds + 131072, (unsigned*)(ws + WS_GATES)}; pg8::gemm_phase<EpiTopK, pg8::StaticOrder>(F.lds, g, S, E); }
    );
    SEAM(5);
    RUNP(6, peer_select_phase(F););
    SEAM(6);
    RUNP(7, peer_dot_phase(F););
    SEAM(7);
    RUNP(8, peer_coef_phase(F););
    SEAM(8);
    RUNP(9, peer_axpy_phase(F););
#undef IN
#undef SEAM
}

extern "C" void kernel_launch(void* const* d_in, const int* in_sizes, int n_in, void* d_out, int out_size, void* d_ws, size_t ws_size, hipStream_t stream) {
    static int grid = 0;
    if (grid == 0) {
        if (n_in != 15 || out_size != MTOK * D || ws_size < WS_END) { fprintf(stderr, "kernel_launch: unexpected shapes (n_in %d out %d ws %zu)\n", n_in, out_size, ws_size); grid = -1; return; }
        int dev = 0, cus = 0, per_cu = 0;
        hipGetDevice(&dev); hipDeviceGetAttribute(&cus, hipDeviceAttributeMultiprocessorCount, dev);
        hipFuncSetAttribute((const void*)fwd_kernel, hipFuncAttributeMaxDynamicSharedMemorySize, LDS_BYTES);
        hipOccupancyMaxActiveBlocksPerMultiprocessor(&per_cu, (const void*)fwd_kernel, NTHR, LDS_BYTES);
        if (per_cu < 1) { fprintf(stderr, "kernel_launch: occupancy query says %d blocks per CU\n", per_cu); per_cu = 1; }
        grid = cus;
        (void)hipGetLastError();
    }
    if (grid < 0) return;
    if (hipMemsetAsync(d_ws, 0, 16384, stream) != hipSuccess) { fprintf(stderr, "kernel_launch: memset of the barrier words failed\n"); return; }
    Args a{};
    for (int i = 0; i < 15; ++i) a.in[i] = (const float*)d_in[i];
    a.out = (float*)d_out; a.ws = (unsigned char*)d_ws;
#if N_LAUNCH == 1
    a.ph_lo = 0; a.ph_hi = 10;
    void* kargs[] = {&a};
    hipError_t e = hipLaunchCooperativeKernel((const void*)fwd_kernel, dim3(grid), dim3(NTHR), kargs, LDS_BYTES, stream);
    if (e != hipSuccess) fprintf(stderr, "cooperative launch failed: %s (grid %d)\n", hipGetErrorString(e), grid);
#else
    for (int p = 0; p < 10; ++p) { a.ph_lo = p; a.ph_hi = p + 1; hipLaunchKernelGGL(fwd_kernel, dim3(grid), dim3(NTHR), LDS_BYTES, stream, a); }
#endif
}
```

```cpp
#include <hip/hip_runtime.h>
#include <hip/hip_cooperative_groups.h>
#include <cstdio>
#include <cstdint>
namespace cg = cooperative_groups;

#ifndef P5_WGM
#define P5_WGM 4
#endif
#ifndef REP_PHASE
#define REP_PHASE -1
#endif
#ifndef N_LAUNCH
#define N_LAUNCH 1
#endif

namespace pg8 {
#define PG8_LAS __attribute__((address_space(3)))
typedef unsigned short bf16_t;
typedef short bf16x8 __attribute__((ext_vector_type(8)));
typedef float f32x4 __attribute__((ext_vector_type(4)));
typedef unsigned u32x4 __attribute__((ext_vector_type(4)));
typedef unsigned u32x2 __attribute__((ext_vector_type(2)));
constexpr int BM = 256, BK = 64, HALF = 128, HTB = HALF * BK * 2, STAGE_BYTES = 8 * HTB, NXCD = 8, WGM = 8;

__host__ __device__ __forceinline__ int lds_byte(int r, int c) { const int st = (r >> 4) * 2 + (c >> 5), rr = r & 15, cc = c & 31, ob = rr * 64 + cc * 2; return st * 1024 + (ob ^ (((ob >> 9) & 1) << 5)); }
__host__ __device__ __forceinline__ void stage_rc(int b, int& R, int& C) { const int st = b / 1024, sb = b % 1024, swz = sb ^ (((sb >> 9) & 1) << 5); R = (st >> 1) * 16 + swz / 64; C = (st & 1) * 32 + (swz % 64) / 2; }
__host__ __device__ __forceinline__ int perm32(int rho) { const int n = rho >> 4, i = rho & 15; return 8 * (i >> 2) + 4 * n + (i & 3); }

struct Unit { int pm, pn; };
struct Gemm { const bf16_t* A; const bf16_t* Bt; int M, N, K, lda, ldb; };

struct StaticOrder {
    int nM, nN, nwg, G, c, wgm;
    __host__ __device__ void init(int M, int N, int G_, int c_, int wgm_ = WGM) { nM = M / BM; nN = N / BM; nwg = nM * nN; G = G_; c = c_; wgm = wgm_; }
    __host__ __device__ bool next(int i, Unit& u) const {
        const long L = (long)i * G + c; if (L >= nwg) return false;
        int wgid = (int)L; { const int q = nwg / NXCD, r = nwg % NXCD, xcd = wgid % NXCD, off = wgid / NXCD; wgid = (xcd < r ? xcd * (q + 1) : r * (q + 1) + (xcd - r) * q) + off; }
        const int nig = wgm * nN, gid = wgid / nig, fm = gid * wgm, gsz = (nM - fm) < wgm ? (nM - fm) : wgm;
        u.pm = fm + ((wgid % nig) % gsz); u.pn = (wgid % nig) / gsz; return true;
    }
};

__device__ __forceinline__ unsigned cvt_pk_bf16(float lo, float hi) { unsigned r; asm volatile("v_cvt_pk_bf16_f32 %0, %1, %2" : "=v"(r) : "v"(lo), "v"(hi)); return r; }

template <class Epi, class Sched, bool CHAIN = false>
__device__ __forceinline__ void gemm_phase(PG8_LAS unsigned char* lds, const Gemm g, const Sched& S, const Epi& E, int chain_kb = 0) {
    const int tid = threadIdx.x, wid = __builtin_amdgcn_readfirstlane(tid >> 6), lane = tid & 63, wr = wid >> 2, wc = wid & 3, fr = lane & 15, fq = lane >> 4;
    const int K = g.K, nt = K / BK;
    unsigned voffA[2], voffB[2];
#pragma unroll
    for (int i = 0; i < 2; ++i) { int R, C; stage_rc(tid * 16 + i * 8192, R, C); const int Rb = Epi::PERM ? ((R & ~31) + perm32(R & 31)) : R;
        voffA[i] = (unsigned)(R * g.lda + C) * 2u; voffB[i] = (unsigned)(Rb * g.ldb + C) * 2u; }
    const size_t kstep = (size_t)(BK * 2);
    const size_t hstepA = (size_t)HALF * g.lda * 2, hstepB = (size_t)HALF * g.ldb * 2;
    const size_t tstepA = 2 * hstepA, tstepB = 2 * hstepB;
    const unsigned ldsw = (unsigned)wid * 1024u;
    const int aoff = lds_byte(wr * 64 + fr, fq * 8), boff = lds_byte(wc * 32 + fr, fq * 8);
#define PG8_SA(b, h) (((b) * 2 + (h)) * HTB)
#define PG8_SB(b, h) ((4 + (b) * 2 + (h)) * HTB)
#define PG8_STAGE(bufoff, gbase, voff) do { _Pragma("unroll") for (int _i = 0; _i < 2; ++_i) \
        __builtin_amdgcn_global_load_lds((const unsigned*)((const char*)(gbase) + (voff)[_i]), (PG8_LAS unsigned*)(lds + (bufoff) + ldsw + _i * 8192), 16, 0, 0); } while (0)
#define PG8_LDA(dst, b, h) do { _Pragma("unroll") for (int m = 0; m < 4; ++m) _Pragma("unroll") for (int k = 0; k < 2; ++k) dst[m][k] = *(const PG8_LAS bf16x8*)(lds + PG8_SA(b, h) + aoff + m * 2048 + k * 1024); } while (0)
#define PG8_LDB(dst, b, h) do { _Pragma("unroll") for (int n = 0; n < 2; ++n) _Pragma("unroll") for (int k = 0; k < 2; ++k) dst[n][k] = *(const PG8_LAS bf16x8*)(lds + PG8_SB(b, h) + boff + n * 2048 + k * 1024); } while (0)
#define PG8_MMA(ai, bj, At, Bt) do { __builtin_amdgcn_s_setprio(1); _Pragma("unroll") for (int m = 0; m < 4; ++m) _Pragma("unroll") for (int n = 0; n < 2; ++n) _Pragma("unroll") for (int k = 0; k < 2; ++k) \
        acc[ai][bj][m][n] = __builtin_amdgcn_mfma_f32_16x16x32_bf16(Bt[n][k], At[m][k], acc[ai][bj][m][n], 0, 0, 0); __builtin_amdgcn_s_setprio(0); } while (0)
#define PG8_WAIT_V(n) asm volatile("s_waitcnt vmcnt(" #n ")" ::: "memory")
#define PG8_WAIT_L(n) asm volatile("s_waitcnt lgkmcnt(" #n ")" ::: "memory")
#define PG8_BAR __builtin_amdgcn_s_barrier()
#define PG8_SCHED __builtin_amdgcn_sched_barrier(0)
    Unit cur, nxt; int ui = 0;
    if (!S.next(0, cur)) return;
    f32x4 acc[2][2][4][2];
#pragma unroll
    for (int a = 0; a < 2; ++a)
#pragma unroll
        for (int b = 0; b < 2; ++b)
#pragma unroll
            for (int m = 0; m < 4; ++m)
#pragma unroll
                for (int n = 0; n < 2; ++n) acc[a][b][m][n] = (f32x4){0.f, 0.f, 0.f, 0.f};
    bf16x8 At[4][2], B0[2][2], B1[2][2];
    const char* cA = (const char*)g.A + (size_t)cur.pm * tstepA; const char* cB = (const char*)g.Bt + (size_t)cur.pn * tstepB;
    PG8_STAGE(PG8_SB(0, 0), cB, voffB); PG8_STAGE(PG8_SB(0, 1), cB + hstepB, voffB); PG8_STAGE(PG8_SA(0, 0), cA, voffA); PG8_STAGE(PG8_SA(0, 1), cA + hstepA, voffA);
    if (wr == 1) PG8_BAR;
    PG8_WAIT_V(2); PG8_BAR;
    PG8_STAGE(PG8_SB(1, 0), cB + kstep, voffB); PG8_STAGE(PG8_SA(1, 0), cA + kstep, voffA); PG8_STAGE(PG8_SB(1, 1), cB + hstepB + kstep, voffB);
    PG8_WAIT_V(6); PG8_BAR;
#define PG8_KLOOP(nA_, nB_) do { _Pragma("unroll 1") for (int t = 0; t < nt; t += 2) { \
            const bool last = (t == nt - 2); \
            const char* a1 = cA + (size_t)(t + 1) * kstep; \
            const char* a2 = last ? (nA_) : cA + (size_t)(t + 2) * kstep; const char* b2 = last ? (nB_) : cB + (size_t)(t + 2) * kstep; \
            const char* a3 = a2 + kstep; const char* b3 = b2 + kstep; \
            PG8_LDB(B0, 0, 0); PG8_LDB(B1, 0, 1); PG8_SCHED; PG8_LDA(At, 0, 0); PG8_STAGE(PG8_SA(1, 1), a1 + hstepA, voffA); \
            PG8_WAIT_V(8); PG8_WAIT_L(0); PG8_BAR; PG8_MMA(0, 0, At, B0); PG8_MMA(0, 1, At, B1); PG8_BAR; PG8_SCHED; \
            PG8_LDA(At, 0, 1); PG8_STAGE(PG8_SB(0, 0), b2, voffB); PG8_STAGE(PG8_SB(0, 1), b2 + hstepB, voffB); PG8_STAGE(PG8_SA(0, 0), a2, voffA); \
            PG8_WAIT_V(8); PG8_WAIT_L(0); PG8_BAR; PG8_MMA(1, 0, At, B0); PG8_MMA(1, 1, At, B1); PG8_BAR; PG8_SCHED; \
            PG8_LDB(B0, 1, 0); PG8_LDB(B1, 1, 1); PG8_SCHED; PG8_LDA(At, 1, 0); PG8_STAGE(PG8_SA(0, 1), a2 + hstepA, voffA); \
            PG8_WAIT_V(8); PG8_WAIT_L(0); PG8_BAR; PG8_MMA(0, 0, At, B0); PG8_MMA(0, 1, At, B1); PG8_BAR; PG8_SCHED; \
            PG8_LDA(At, 1, 1); PG8_STAGE(PG8_SB(1, 0), b3, voffB); PG8_STAGE(PG8_SB(1, 1), b3 + hstepB, voffB); PG8_STAGE(PG8_SA(1, 0), a3, voffA); \
            PG8_WAIT_V(8); PG8_WAIT_L(0); PG8_BAR; PG8_MMA(1, 0, At, B0); PG8_MMA(1, 1, At, B1); PG8_BAR; PG8_SCHED; \
        } } while (0)
    for (;;) {
        const bool has_next = S.next(ui + 1, nxt);
        if constexpr (CHAIN) {
            const char* mA = cA + chain_kb; const char* mB = cB + chain_kb;
            PG8_KLOOP(mA, mB);
            if (wr == 0) PG8_BAR;
            E.mid(acc, cur, wr, wc, fr, fq);
            cA = mA; cB = mB;
            if (wr == 1) PG8_BAR;
        }
        const char* nA = has_next ? (const char*)g.A + (size_t)nxt.pm * tstepA : cA; const char* nB = has_next ? (const char*)g.Bt + (size_t)nxt.pn * tstepB : cB;
        PG8_KLOOP(nA, nB);
        if (wr == 0) PG8_BAR;
        E(acc, cur, wr, wc, fr, fq);
        if (!has_next) break;
#pragma unroll
        for (int a = 0; a < 2; ++a)
#pragma unroll
            for (int b = 0; b < 2; ++b)
#pragma unroll
                for (int m = 0; m < 4; ++m)
#pragma unroll
                    for (int n = 0; n < 2; ++n) acc[a][b][m][n] = (f32x4){0.f, 0.f, 0.f, 0.f};
        cur = nxt; cA = nA; cB = nB; ++ui;
        if (wr == 1) PG8_BAR;
    }
#undef PG8_KLOOP
    PG8_WAIT_V(0);
    PG8_BAR;
#undef PG8_SA
#undef PG8_SB
#undef PG8_STAGE
#undef PG8_LDA
#undef PG8_LDB
#undef PG8_MMA
#undef PG8_WAIT_V
#undef PG8_WAIT_L
#undef PG8_BAR
#undef PG8_SCHED
}

template <class Epi, class Sched>
__device__ __forceinline__ void gemm_phase_fp8(PG8_LAS unsigned char* lds, const Gemm g, const Sched& S, const Epi& E) {
    const int tid = threadIdx.x, wid = __builtin_amdgcn_readfirstlane(tid >> 6), lane = tid & 63, wr = wid >> 2, wc = wid & 3, fr = lane & 15, fq = lane >> 4;
    const int K = g.K, nt = K / BK;
    unsigned voffA[2], voffB[2];
#pragma unroll
    for (int i = 0; i < 2; ++i) { int R, C; stage_rc(tid * 16 + i * 8192, R, C); const int Rb = Epi::PERM ? ((R & ~31) + perm32(R & 31)) : R;
        voffA[i] = (unsigned)(R * g.lda + C) * 2u; voffB[i] = (unsigned)(Rb * g.ldb + C) * 2u; }
    const size_t kstep = (size_t)(BK * 2);
    const size_t hstepA = (size_t)HALF * g.lda * 2, hstepB = (size_t)HALF * g.ldb * 2;
    const size_t tstepA = 2 * hstepA, tstepB = 2 * hstepB;
    const unsigned ldsw = (unsigned)wid * 1024u;
    const int aoff = lds_byte(wr * 64 + fr, fq * 8), boff = lds_byte(wc * 32 + fr, fq * 8);
#define PG8_SA(b, h) (((b) * 2 + (h)) * HTB)
#define PG8_SB(b, h) ((4 + (b) * 2 + (h)) * HTB)
#define PG8_STAGE(bufoff, gbase, voff) do { _Pragma("unroll") for (int _i = 0; _i < 2; ++_i) \
        __builtin_amdgcn_global_load_lds((const unsigned*)((const char*)(gbase) + (voff)[_i]), (PG8_LAS unsigned*)(lds + (bufoff) + ldsw + _i * 8192), 16, 0, 0); } while (0)
#define PG8_LDA(dst, b, h) do { _Pragma("unroll") for (int m = 0; m < 4; ++m) { const i32x4_ l0_ = *(const PG8_LAS i32x4_*)(lds + PG8_SA(b, h) + aoff + m * 2048), l1_ = *(const PG8_LAS i32x4_*)(lds + PG8_SA(b, h) + aoff + m * 2048 + 1024); \
        dst[m] = __builtin_shufflevector(l0_, l1_, 0, 1, 2, 3, 4, 5, 6, 7); } } while (0)
#define PG8_LDB(dst, b, h) do { _Pragma("unroll") for (int n = 0; n < 2; ++n) { const i32x4_ l0_ = *(const PG8_LAS i32x4_*)(lds + PG8_SB(b, h) + boff + n * 2048), l1_ = *(const PG8_LAS i32x4_*)(lds + PG8_SB(b, h) + boff + n * 2048 + 1024); \
        dst[n] = __builtin_shufflevector(l0_, l1_, 0, 1, 2, 3, 4, 5, 6, 7); } } while (0)
#define PG8_MMA(ai, bj, At, Bt) do { __builtin_amdgcn_s_setprio(1); _Pragma("unroll") for (int m = 0; m < 4; ++m) _Pragma("unroll") for (int n = 0; n < 2; ++n) { \
        if constexpr (true) { asm volatile("v_mfma_scale_f32_16x16x128_f8f6f4 %0, %1, %2, %0, %3, %3 op_sel_hi:[0,0,0]" : "+v"(acc[ai][bj][m][n]) : "v"(Bt[n]), "v"(At[m]), "v"(scl_)); }     \
        else { acc[ai][bj][m][n] = __builtin_amdgcn_mfma_f32_16x16x32_bf16(__builtin_bit_cast(bf16x8, __builtin_shufflevector(Bt[n], Bt[n], 0, 1, 2, 3)), __builtin_bit_cast(bf16x8, __builtin_shufflevector(At[m], At[m], 0, 1, 2, 3)), acc[ai][bj][m][n], 0, 0, 0); \
               acc[ai][bj][m][n] = __builtin_amdgcn_mfma_f32_16x16x32_bf16(__builtin_bit_cast(bf16x8, __builtin_shufflevector(Bt[n], Bt[n], 4, 5, 6, 7)), __builtin_bit_cast(bf16x8, __builtin_shufflevector(At[m], At[m], 4, 5, 6, 7)), acc[ai][bj][m][n], 0, 0, 0); } } \
        __builtin_amdgcn_s_setprio(0); } while (0)
#define PG8_WAIT_V(n) asm volatile("s_waitcnt vmcnt(" #n ")" ::: "memory")
#define PG8_WAIT_L(n) asm volatile("s_waitcnt lgkmcnt(" #n ")" ::: "memory")
#define PG8_BAR __builtin_amdgcn_s_barrier()
#define PG8_SCHED __builtin_amdgcn_sched_barrier(0)
    Unit cur, nxt; int ui = 0;
    if (!S.next(0, cur)) return;
    f32x4 acc[2][2][4][2];
#pragma unroll
    for (int a = 0; a < 2; ++a)
#pragma unroll
        for (int b = 0; b < 2; ++b)
#pragma unroll
            for (int m = 0; m < 4; ++m)
#pragma unroll
                for (int n = 0; n < 2; ++n) acc[a][b][m][n] = (f32x4){0.f, 0.f, 0.f, 0.f};
    __builtin_amdgcn_sched_barrier(0); asm volatile("s_nop 7" ::: "memory"); __builtin_amdgcn_sched_barrier(0);
    typedef int i32x4_ __attribute__((ext_vector_type(4))); typedef int i32x8_ __attribute__((ext_vector_type(8)));
    i32x8_ At[4], B0[2], B1[2];
    int scl_ = 0x7f7f7f7f; asm volatile("" : "+v"(scl_));
    const char* cA = (const char*)g.A + (size_t)cur.pm * tstepA; const char* cB = (const char*)g.Bt + (size_t)cur.pn * tstepB;
    PG8_STAGE(PG8_SB(0, 0), cB, voffB); PG8_STAGE(PG8_SB(0, 1), cB + hstepB, voffB); PG8_STAGE(PG8_SA(0, 0), cA, voffA); PG8_STAGE(PG8_SA(0, 1), cA + hstepA, voffA);
    if (wr == 1) PG8_BAR;
    PG8_WAIT_V(2); PG8_BAR;
    PG8_STAGE(PG8_SB(1, 0), cB + kstep, voffB); PG8_STAGE(PG8_SA(1, 0), cA + kstep, voffA); PG8_STAGE(PG8_SB(1, 1), cB + hstepB + kstep, voffB);
    PG8_WAIT_V(6); PG8_BAR;
    for (;;) {
        const bool has_next = S.next(ui + 1, nxt);
        const char* nA = has_next ? (const char*)g.A + (size_t)nxt.pm * tstepA : cA; const char* nB = has_next ? (const char*)g.Bt + (size_t)nxt.pn * tstepB : cB;
#pragma unroll 1
        for (int t = 0; t < nt; t += 2) {
            const bool last = (t == nt - 2);
            const char* a1 = cA + (size_t)(t + 1) * kstep;
            const char* a2 = last ? nA : cA + (size_t)(t + 2) * kstep; const char* b2 = last ? nB : cB + (size_t)(t + 2) * kstep;
            const char* a3 = a2 + kstep; const char* b3 = b2 + kstep;
            PG8_LDB(B0, 0, 0); PG8_LDB(B1, 0, 1); PG8_SCHED; PG8_LDA(At, 0, 0); PG8_STAGE(PG8_SA(1, 1), a1 + hstepA, voffA);
            PG8_WAIT_V(8); PG8_WAIT_L(0); PG8_BAR; PG8_MMA(0, 0, At, B0); PG8_MMA(0, 1, At, B1); PG8_BAR; PG8_SCHED;
            PG8_LDA(At, 0, 1); PG8_STAGE(PG8_SB(0, 0), b2, voffB); PG8_STAGE(PG8_SB(0, 1), b2 + hstepB, voffB); PG8_STAGE(PG8_SA(0, 0), a2, voffA);
            PG8_WAIT_V(8); PG8_WAIT_L(0); PG8_BAR; PG8_MMA(1, 0, At, B0); PG8_MMA(1, 1, At, B1); PG8_BAR; PG8_SCHED;
            PG8_LDB(B0, 1, 0); PG8_LDB(B1, 1, 1); PG8_SCHED; PG8_LDA(At, 1, 0); PG8_STAGE(PG8_SA(0, 1), a2 + hstepA, voffA);
            PG8_WAIT_V(8); PG8_WAIT_L(0); PG8_BAR; PG8_MMA(0, 0, At, B0); PG8_MMA(0, 1, At, B1); PG8_BAR; PG8_SCHED;
            PG8_LDA(At, 1, 1); PG8_STAGE(PG8_SB(1, 0), b3, voffB); PG8_STAGE(PG8_SB(1, 1), b3 + hstepB, voffB); PG8_STAGE(PG8_SA(1, 0), a3, voffA);
            PG8_WAIT_V(8); PG8_WAIT_L(0); PG8_BAR; PG8_MMA(1, 0, At, B0); PG8_MMA(1, 1, At, B1); PG8_BAR; PG8_SCHED;
        }
        if (wr == 0) PG8_BAR;
        __builtin_amdgcn_sched_barrier(0); asm volatile("s_nop 15\n\ts_nop 15\n\ts_nop 15\n\ts_nop 15\n\ts_nop 15\n\ts_nop 15" ::: "memory"); __builtin_amdgcn_sched_barrier(0);
        E(acc, cur, wr, wc, fr, fq);
        if (!has_next) break;
#pragma unroll
        for (int a = 0; a < 2; ++a)
#pragma unroll
            for (int b = 0; b < 2; ++b)
#pragma unroll
                for (int m = 0; m < 4; ++m)
#pragma unroll
                    for (int n = 0; n < 2; ++n) acc[a][b][m][n] = (f32x4){0.f, 0.f, 0.f, 0.f};
        __builtin_amdgcn_sched_barrier(0); asm volatile("s_nop 7" ::: "memory"); __builtin_amdgcn_sched_barrier(0);
        cur = nxt; cA = nA; cB = nB; ++ui;
        if (wr == 1) PG8_BAR;
    }
    PG8_WAIT_V(0);
    PG8_BAR;
#undef PG8_SA
#undef PG8_SB
#undef PG8_STAGE
#undef PG8_LDA
#undef PG8_LDB
#undef PG8_MMA
#undef PG8_WAIT_V
#undef PG8_WAIT_L
#undef PG8_BAR
#undef PG8_SCHED
}
}

constexpr int D = 1024, BATCH = 32, SEQ = 2048, MTOK = BATCH * SEQ;
constexpr int N1 = 3840;
constexpr int NEXP = 16384;
constexpr float RMS_EPS = 1e-6f;
constexpr float LOG2E = 1.4426950408889634f;
constexpr float SB_EXIT = -40.f;

constexpr size_t MiB = 1u << 20;
constexpr size_t WS_W1T = 2 * MiB;
constexpr size_t WS_WVBT = 10 * MiB;
constexpr size_t WS_WUPT = 12 * MiB;
constexpr size_t WS_WOUTT = 14 * MiB;
constexpr size_t WS_WST = 16 * MiB;
constexpr size_t WS_SSQ = 20 * MiB;
constexpr size_t WS_SU = 24 * MiB;
constexpr size_t WS_SV = 25 * MiB;
constexpr size_t WS_SCT = 27 * MiB;
constexpr size_t WS_UT = 32 * MiB;
constexpr size_t WS_VT = 64 * MiB;
constexpr size_t WS_H = 96 * MiB;
constexpr size_t WS_QA = 224 * MiB;
constexpr size_t WS_KA = 288 * MiB;
constexpr size_t WS_VA = 304 * MiB;
constexpr size_t WS_QB = 320 * MiB;
constexpr size_t WS_KB = 384 * MiB;
constexpr size_t WS_VBT = 448 * MiB;
constexpr size_t WS_GATES = 512 * MiB;
constexpr size_t WS_MERGED = 768 * MiB;
constexpr size_t WS_WG8T = 28 * MiB;
constexpr size_t WS_H8 = 768 * MiB;
constexpr size_t WS_WOUT8T = 31 * MiB;
constexpr size_t WS_M8 = 224 * MiB;
constexpr size_t WS_RSTD = 26 * MiB + 512 * 1024;
constexpr size_t WS_SXR = 26 * MiB;
constexpr size_t WS_PE = 224 * MiB;
constexpr size_t WS_PG = 256 * MiB;
constexpr size_t WS_PC = 288 * MiB;
constexpr size_t WS_XQ = 320 * MiB;
constexpr size_t WS_PD = 384 * MiB;
constexpr size_t WS_END = 896 * MiB;

constexpr int LDS_BYTES = 155648;
constexpr int NTHR = 512;

#define LAS __attribute__((address_space(3)))
typedef unsigned short bf16;
typedef float f32x4 __attribute__((ext_vector_type(4)));
typedef float f32x16 __attribute__((ext_vector_type(16)));
typedef float f32x2 __attribute__((ext_vector_type(2)));
typedef short bf16x8 __attribute__((ext_vector_type(8)));
typedef unsigned u32x4 __attribute__((ext_vector_type(4)));
typedef unsigned u32x2 __attribute__((ext_vector_type(2)));
typedef __bf16 bf16v2 __attribute__((ext_vector_type(2)));

__device__ __forceinline__ unsigned f2bf(float f) { unsigned u = __builtin_bit_cast(unsigned, f); return (u + 0x7fffu + ((u >> 16) & 1u)) >> 16; }
__device__ __forceinline__ unsigned pk2(float lo, float hi) { return f2bf(lo) | (f2bf(hi) << 16); }
__device__ __forceinline__ float bflo(unsigned w) { return __builtin_bit_cast(float, w << 16); }
__device__ __forceinline__ float bfhi(unsigned w) { return __builtin_bit_cast(float, w & 0xffff0000u); }
__device__ __forceinline__ float wave_sum(float v) {
#pragma unroll
    for (int o = 1; o < 64; o <<= 1) v += __shfl_xor(v, o);
    return v;
}
__device__ __forceinline__ float dot2bf(unsigned w, unsigned x, float acc) { return __builtin_amdgcn_fdot2_f32_bf16(__builtin_bit_cast(bf16v2, w), __builtin_bit_cast(bf16v2, x), acc, false); }
__device__ __forceinline__ float fast_exp2(float x) { return __builtin_amdgcn_exp2f(x); }
__device__ __forceinline__ float fast_log2(float x) { return __builtin_amdgcn_logf(x); }
__device__ __forceinline__ float fast_rcp(float x) { return __builtin_amdgcn_rcpf(x); }
__device__ __forceinline__ float gelu_erf(float v) {
    const float av = fabsf(v), t = fast_rcp(av * 0.2316418882f + 1.0f);
    float q = t * 0.5307027145f + (-0.7265760135f); q = q * t + 0.7107068705f; q = q * t + (-0.142248368f); q = q * t + 0.127414796f; q = q * t;
    const float e = fast_exp2((v * v) * (-0.72134752044f));
    const float m = v * (q * e);
    return v < 0.f ? m : v - m;
}

struct Args { const float* in[15]; float* out; unsigned char* ws; int ph_lo, ph_hi; };

struct Ctx {
    LAS unsigned char* lds;
    int tid, lane, wave, G, bid;
    const float *x, *g1, *w_in, *gate_bias, *qgain, *kgain, *sinks, *w_up_a, *w_up_b, *w_out, *g2, *w_q, *sub_keys, *pu, *pv;
    float* out; unsigned char* ws;
};


#define XB_TMO      128
#define XB_XCNT(j)  (256  + 64 * (j))
#define XB_XSUB(j)  (1280 + 64 * (j))
#define XB_XGEN(j)  (2304 + 64 * (j))
#define XB_TOP      3328
#define XB_TOPGEN   3392
#define XCD_BAR_WORDS 3456
#define XB_SPIN_CAP (1u << 18)
__device__ __forceinline__ unsigned xb_ld(unsigned* p)              { return __hip_atomic_load(p, __ATOMIC_RELAXED, __HIP_MEMORY_SCOPE_AGENT); }
__device__ __forceinline__ unsigned xb_add(unsigned* p, unsigned v) { return __hip_atomic_fetch_add(p, v, __ATOMIC_RELAXED, __HIP_MEMORY_SCOPE_AGENT); }
__device__ __forceinline__ unsigned xb_xcc_id() { return (unsigned)__builtin_amdgcn_s_getreg((3 << 11) | 20) & 0xFu; }
#define XB_SPIN(cond, bar) do { unsigned _sp = 0; while (cond) { __builtin_amdgcn_s_sleep(1); \
    if ((++_sp & 255u) == 0u) { if (xb_ld(&(bar)[XB_TMO])) break; if (_sp > XB_SPIN_CAP) { atomicAdd(&(bar)[XB_TMO], 1u); break; } } } } while (0)
struct XcdBarrier { unsigned* bar; unsigned x; volatile __attribute__((address_space(3))) unsigned* st; };
__device__ __forceinline__ XcdBarrier xcd_barrier_post(unsigned* bar, volatile __attribute__((address_space(3))) unsigned* st) {
    XcdBarrier b; b.bar = bar; b.x = xb_xcc_id(); b.st = st;
    if (threadIdx.x == 0) (void)xb_add(&bar[XB_XCNT(b.x)], 1u);
    return b;
}
__device__ __forceinline__ void xcd_barrier_complete(unsigned* bar, unsigned x, unsigned& nloc, unsigned& nx) {
    const unsigned G = gridDim.x * gridDim.y * gridDim.z;
    unsigned sum, cnt, mine, sp = 0u;
    for (;;) {
        sum = 0u; cnt = 0u; mine = 0u;
#pragma unroll
        for (unsigned j = 0; j < 16; ++j) { const unsigned c = xb_ld(&bar[XB_XCNT(j)]); sum += c; cnt += (c > 0u) ? 1u : 0u; mine = (j == x) ? c : mine; }
        if (sum == G) break;
        __builtin_amdgcn_s_sleep(1);
        if ((++sp & 255u) == 0u) { if (xb_ld(&bar[XB_TMO])) break; if (sp > XB_SPIN_CAP) { atomicAdd(&bar[XB_TMO], 1u); break; } }
    }
    nloc = mine > 0u ? mine : 1u; nx = cnt > 0u ? cnt : 1u;
}
__device__ __forceinline__ void xcd_barrier(const XcdBarrier& b) {
    asm volatile("s_waitcnt vmcnt(0)" ::: "memory");
    __syncthreads();
    if (threadIdx.x == 0) {
        unsigned* bar = b.bar;
        __builtin_amdgcn_s_waitcnt(0);
        unsigned nloc = b.st[0], nx = b.st[1];
        if (nloc == 0u) { xcd_barrier_complete(bar, b.x, nloc, nx); b.st[0] = nloc; b.st[1] = nx; }
        const unsigned old = xb_add(&bar[XB_XSUB(b.x)], 1u);
        const unsigned gen = old / nloc;
        if (old + 1u == (gen + 1u) * nloc) {
            __builtin_amdgcn_fence(__ATOMIC_RELEASE, "agent");
            asm volatile("s_waitcnt vmcnt(0)" ::: "memory");
            const unsigned og = xb_add(&bar[XB_TOP], 1u);
            const unsigned tg = og / nx;
            if (og + 1u == (tg + 1u) * nx) xb_add(&bar[XB_TOPGEN], 1u);
            else XB_SPIN(xb_ld(&bar[XB_TOPGEN]) == tg, bar);
            __builtin_amdgcn_fence(__ATOMIC_ACQUIRE, "agent");
            xb_add(&bar[XB_XGEN(b.x)], 1u);
            asm volatile("s_waitcnt vmcnt(0)" ::: "memory");
        } else {
            XB_SPIN(xb_ld(&bar[XB_XGEN(b.x)]) == gen, bar);
            __builtin_amdgcn_fence(__ATOMIC_ACQUIRE, "agent");
            asm volatile("s_waitcnt vmcnt(0)" ::: "memory");
        }
    }
    __syncthreads();
}

__device__ __forceinline__ void transpose_item(const float* W, int ldw, int k0, int ncol0, bf16* WTrow0  , int ldt, LAS float* scr, int lane) {
#pragma unroll 8
    for (int i = 0; i < 32; ++i) { const int kk = 2 * i + (lane >> 5); scr[kk * 33 + (lane & 31)] = W[(size_t)(k0 + kk) * ldw + ncol0 + (lane & 31)]; }
    asm volatile("s_waitcnt lgkmcnt(0)" ::: "memory");
    const int c = lane & 7;
#pragma unroll
    for (int j = 0; j < 4; ++j) { const int n = (lane >> 3) + 8 * j; const LAS float* s = scr + (8 * c) * 33 + n;
        u32x4 o; o.x = pk2(s[0 * 33], s[1 * 33]); o.y = pk2(s[2 * 33], s[3 * 33]); o.z = pk2(s[4 * 33], s[5 * 33]); o.w = pk2(s[6 * 33], s[7 * 33]);
        *(u32x4*)(WTrow0 + (size_t)n * ldt + k0 + 8 * c) = o; }
    asm volatile("s_waitcnt lgkmcnt(0)" ::: "memory");
}

__device__ __forceinline__ void transpose_item_fp8(const float* W, int ldw, int k0, int ncol0, unsigned char* WTrow0, int ldt, float scale, LAS float* scr, int lane) {
#pragma unroll 8
    for (int i = 0; i < 32; ++i) { const int kk = 2 * i + (lane >> 5); scr[kk * 33 + (lane & 31)] = W[(size_t)(k0 + kk) * ldw + ncol0 + (lane & 31)]; }
    asm volatile("s_waitcnt lgkmcnt(0)" ::: "memory");
    const int n = lane >> 1, kh = (lane & 1) * 32; const LAS float* sp = scr + kh * 33 + n;
    u32x4 o0, o1;
#pragma unroll
    for (int j = 0; j < 4; ++j) { int w = __builtin_amdgcn_cvt_pk_fp8_f32(sp[(4 * j) * 33] * scale, sp[(4 * j + 1) * 33] * scale, 0, false); w = __builtin_amdgcn_cvt_pk_fp8_f32(sp[(4 * j + 2) * 33] * scale, sp[(4 * j + 3) * 33] * scale, w, true); o0[j] = (unsigned)w;
        int w2 = __builtin_amdgcn_cvt_pk_fp8_f32(sp[(16 + 4 * j) * 33] * scale, sp[(16 + 4 * j + 1) * 33] * scale, 0, false); w2 = __builtin_amdgcn_cvt_pk_fp8_f32(sp[(16 + 4 * j + 2) * 33] * scale, sp[(16 + 4 * j + 3) * 33] * scale, w2, true); o1[j] = (unsigned)w2; }
    *(u32x4*)(WTrow0 + (size_t)n * ldt + k0 + kh) = o0; *(u32x4*)(WTrow0 + (size_t)n * ldt + k0 + kh + 16) = o1;
    asm volatile("s_waitcnt lgkmcnt(0)" ::: "memory");
}

__device__ __forceinline__ void p0_prep(Ctx& F) {
    unsigned char* ws = F.ws;
    const bool prep_role = (F.bid & 3) == 3 && F.G >= 4;
    const int nprep = F.G >= 4 ? F.G / 4 : 0, nstream = F.G - nprep;
    const int sidx = F.G >= 4 ? (F.bid >> 2) * 3 + (F.bid & 3) : F.bid;
    const int gw = (prep_role ? (F.bid >> 2) : sidx) * 8 + F.wave, NGW = (prep_role ? nprep : nstream) * 8;
    if (!prep_role || F.G < 4) {
        bf16* H = (bf16*)(ws + WS_H);
        f32x4 gn[4];
#pragma unroll
        for (int j = 0; j < 4; ++j) gn[j] = *((const f32x4*)F.g1 + F.lane + 64 * j);
        for (int m4 = gw; m4 < MTOK / 4; m4 += NGW) {
            f32x4 v[4][4];
#pragma unroll
            for (int q = 0; q < 4; ++q) { const f32x4* xr = (const f32x4*)(F.x + (size_t)(m4 * 4 + q) * D) + F.lane;
#pragma unroll
                for (int j = 0; j < 4; ++j) v[q][j] = xr[64 * j]; }
            __builtin_amdgcn_sched_barrier(0);
#pragma unroll
            for (int q = 0; q < 4; ++q) { const int m = m4 * 4 + q; float s = 0.f;
#pragma unroll
                for (int j = 0; j < 4; ++j) s += (v[q][j].x * v[q][j].x + v[q][j].y * v[q][j].y) + (v[q][j].z * v[q][j].z + v[q][j].w * v[q][j].w);
                const float r = 1.0f / sqrtf(wave_sum(s) * (1.f / D) + RMS_EPS);
                u32x2* o8 = (u32x2*)(H + (size_t)m * D) + F.lane; unsigned* o4 = (unsigned*)(ws + WS_H8 + (size_t)m * D) + F.lane;
#pragma unroll
                for (int j = 0; j < 4; ++j) { const float h0 = v[q][j].x * r * gn[j].x, h1 = v[q][j].y * r * gn[j].y, h2 = v[q][j].z * r * gn[j].z, h3 = v[q][j].w * r * gn[j].w;
                    u32x2 o; o.x = pk2(h0, h1); o.y = pk2(h2, h3); o8[64 * j] = o;
                    int w8 = __builtin_amdgcn_cvt_pk_fp8_f32(h0, h1, 0, false); w8 = __builtin_amdgcn_cvt_pk_fp8_f32(h2, h3, w8, true); o4[64 * j] = (unsigned)w8; } }
        }
    }
    if (prep_role || F.G < 4) {
        LAS float* scr = (LAS float*)(F.lds + F.wave * 16384);
        bf16* W1T = (bf16*)(ws + WS_W1T); bf16* WVBT = (bf16*)(ws + WS_WVBT); bf16* WUPT = (bf16*)(ws + WS_WUPT); bf16* WOUTT = (bf16*)(ws + WS_WOUTT);
        constexpr int I_IN = 16 * 136, I_UP = 8 * 32, I_OUT = 16 * 32, NIT = I_IN + 2 * I_UP + I_OUT;
        for (int it = gw; it < NIT; it += NGW) {
            int r = it;
            if (r < I_IN) { const int kb = r / 136, nb = r % 136, n0 = nb * 32;
                if (n0 < 768 || n0 >= 2304) { transpose_item_fp8(F.w_in, 4352, kb * 64, n0, ws + WS_WG8T + (size_t)(n0 < 768 ? n0 : n0 - 2304 + 768) * D, D, 64.f, scr, F.lane); continue; }
                bf16* dst = n0 < 1792 ? W1T + (size_t)(n0 - 768) * D : WVBT + (size_t)(n0 - 1792) * D;
                transpose_item(F.w_in, 4352, kb * 64, n0, dst, D, scr, F.lane); continue; }
            r -= I_IN;
            if (r < I_UP) { const int kb = r / 32, nb = r % 32; transpose_item(F.w_up_a, D, kb * 64, nb * 32, WUPT + (size_t)(nb * 32) * D, D, scr, F.lane); continue; }
            r -= I_UP;
            if (r < I_UP) { const int kb = r / 32, nb = r % 32; transpose_item(F.w_up_b, D, kb * 64, nb * 32, WUPT + (size_t)(nb * 32) * D + 512, D, scr, F.lane); continue; }
            r -= I_UP;
            { const int kb = r / 32, nb = r % 32; transpose_item_fp8(F.w_out, D, kb * 64, nb * 32, ws + WS_WOUT8T + (size_t)(nb * 32) * D, D, 64.f, scr, F.lane); }
        }
    }
    __syncthreads();
    if (prep_role || F.G < 4) {
        bf16* WST = (bf16*)(ws + WS_WST);
        LAS float* Wq = (LAS float*)F.lds;
        LAS float* SK = (LAS float*)(F.lds + 32768);
        for (int it = (F.G >= 4 ? (F.bid >> 2) : F.bid); it < 256; it += (F.G >= 4 ? nprep : F.G)) {
            const int hp = it >> 4, kb = it & 15, k0 = kb * 64;
#pragma unroll
            for (int j = 0; j < 4; ++j) { const int r = (F.tid >> 5) + 16 * j, c4 = F.tid & 31;
                const f32x4 v = *(const f32x4*)(F.w_q + (size_t)(k0 + r) * 2048 + hp * 128 + c4 * 4);
                *(LAS f32x4*)(Wq + r * 128 + c4 * 4) = v; }
#pragma unroll
            for (int j = 0; j < 8; ++j) { const int r = (F.tid >> 5) + 16 * j, c4 = F.tid & 31;
                const f32x4 v = *(const f32x4*)(F.sub_keys + ((size_t)hp * 128 + r) * 128 + c4 * 4);
                LAS float* d = SK + r * 129 + c4 * 4; d[0] = v.x; d[1] = v.y; d[2] = v.z; d[3] = v.w; }
            __syncthreads();
            const int key = F.tid & 127, kq = F.tid >> 7;
            float a[16];
#pragma unroll
            for (int i = 0; i < 16; ++i) a[i] = 0.f;
            for (int d = 0; d < 128; ++d) { const float s = SK[key * 129 + d];
#pragma unroll
                for (int i = 0; i < 16; ++i) a[i] += Wq[(kq * 16 + i) * 128 + d] * s; }
            const float* gp = F.g2 + k0 + kq * 16;
            u32x4 o0, o1;
            o0.x = pk2(a[0] * gp[0], a[1] * gp[1]); o0.y = pk2(a[2] * gp[2], a[3] * gp[3]); o0.z = pk2(a[4] * gp[4], a[5] * gp[5]); o0.w = pk2(a[6] * gp[6], a[7] * gp[7]);
            o1.x = pk2(a[8] * gp[8], a[9] * gp[9]); o1.y = pk2(a[10] * gp[10], a[11] * gp[11]); o1.z = pk2(a[12] * gp[12], a[13] * gp[13]); o1.w = pk2(a[14] * gp[14], a[15] * gp[15]);
            u32x4* dst = (u32x4*)(WST + (size_t)(hp * 128 + key) * D + k0 + kq * 16);
            dst[0] = o0; dst[1] = o1;
            __syncthreads();
        }
    }
    if (!prep_role || F.G < 4) {
        unsigned char* UT8 = ws + WS_UT; unsigned char* VT8 = ws + WS_VT; float* SU = (float*)(ws + WS_SU); float* SV = (float*)(ws + WS_SV);
        f32x4 gn[4];
#pragma unroll
        for (int j = 0; j < 4; ++j) gn[j] = *((const f32x4*)F.g2 + F.lane * 4 + j);
        for (int e2 = gw; e2 < NEXP / 2; e2 += NGW) {
            f32x4 av[2][4], bv[2][4];
#pragma unroll
            for (int q = 0; q < 2; ++q) { const f32x4* up = (const f32x4*)(F.pu + (size_t)(e2 * 2 + q) * D) + F.lane * 4; const f32x4* vp = (const f32x4*)(F.pv + (size_t)(e2 * 2 + q) * D) + F.lane * 4;
#pragma unroll
                for (int j = 0; j < 4; ++j) { av[q][j] = up[j]; bv[q][j] = vp[j]; } }
            __builtin_amdgcn_sched_barrier(0);
#pragma unroll
            for (int q = 0; q < 2; ++q) { const int e = e2 * 2 + q;
            f32x4 a[4], b[4]; float mu = 0.f, mv = 0.f;
#pragma unroll
            for (int j = 0; j < 4; ++j) { a[j] = av[q][j] * gn[j]; b[j] = bv[q][j];
                mu = fmaxf(mu, fmaxf(fmaxf(fabsf(a[j].x), fabsf(a[j].y)), fmaxf(fabsf(a[j].z), fabsf(a[j].w))));
                mv = fmaxf(mv, fmaxf(fmaxf(fabsf(b[j].x), fabsf(b[j].y)), fmaxf(fabsf(b[j].z), fabsf(b[j].w)))); }
#pragma unroll
            for (int o = 1; o < 64; o <<= 1) { mu = fmaxf(mu, __shfl_xor(mu, o)); mv = fmaxf(mv, __shfl_xor(mv, o)); }
            const float su = mu > 0.f ? mu * (1.f / 127.f) : 1.f, sv = mv > 0.f ? mv * (1.f / 127.f) : 1.f;
            const float iu = 1.f / su, iv = 1.f / sv;
            u32x4 qu, qv;
#pragma unroll
            for (int j = 0; j < 4; ++j) {
                const int q0 = (int)rintf(a[j].x * iu), q1 = (int)rintf(a[j].y * iu), q2 = (int)rintf(a[j].z * iu), q3 = (int)rintf(a[j].w * iu);
                qu[j] = (unsigned)(q0 & 255) | ((unsigned)(q1 & 255) << 8) | ((unsigned)(q2 & 255) << 16) | ((unsigned)(q3 & 255) << 24);
                const int r0 = (int)rintf(b[j].x * iv), r1 = (int)rintf(b[j].y * iv), r2 = (int)rintf(b[j].z * iv), r3 = (int)rintf(b[j].w * iv);
                qv[j] = (unsigned)(r0 & 255) | ((unsigned)(r1 & 255) << 8) | ((unsigned)(r2 & 255) << 16) | ((unsigned)(r3 & 255) << 24); }
            { const size_t so = ((size_t)(F.lane >> 3) * NEXP + e) * 128 + (F.lane & 7) * 16;
              *(u32x4*)(UT8 + so) = qu; *(u32x4*)(VT8 + so) = qv; }
            if (F.lane == 0) { SU[e] = su; SV[e] = sv; }
            }
        }
    }
}

struct Epi1 {
    static constexpr bool PERM = true;
    unsigned char* ws; LAS const float* gate_bias; float gate_scale, out_scale;
    __device__ __forceinline__ void operator()(const f32x4 (&acc)[2][2][4][2], const pg8::Unit& u, int wr, int wc, int fr, int fq) const {
        const int row0 = u.pm * 256 + wr * 64 + fr; const int pn = u.pn;
#pragma unroll
        for (int bj = 0; bj < 2; ++bj) {
            bf16* base; int ldc, col; float sc = 1.f; bool gate = false;
            const int cin = bj * 128 + wc * 32 + 8 * fq;
            if (pn < 2) { base = (bf16*)(ws + WS_QA); ldc = 512; col = pn * 256 + cin; }
            else if (pn == 2) { base = (bf16*)(ws + (bj == 0 ? WS_KA : WS_VA)); ldc = 128; col = wc * 32 + 8 * fq; }
            else if (pn < 5) { base = (bf16*)(ws + WS_QB); ldc = 512; col = (pn - 3) * 256 + cin; sc = LOG2E * 0.125f; }
            else if (pn < 7) { base = (bf16*)(ws + WS_KB); ldc = 512; col = (pn - 5) * 256 + cin; }
            else { base = (bf16*)(ws + WS_GATES); ldc = 2048; col = (pn - 7) * 256 + cin; gate = true; }
            f32x4 b0 = {0.f, 0.f, 0.f, 0.f}, b1 = {0.f, 0.f, 0.f, 0.f};
            if (gate) { b0 = *(LAS const f32x4*)(gate_bias + col) * (-LOG2E); b1 = *(LAS const f32x4*)(gate_bias + col + 4) * (-LOG2E); }
            const float gs = -LOG2E * gate_scale;
            const size_t esz = gate ? 1 : 2, rstep = (size_t)ldc * 16 * esz;
            unsigned char* rp = (unsigned char*)base + ((size_t)row0 * ldc + col) * esz;
#pragma unroll
            for (int ai = 0; ai < 2; ++ai) {
#pragma unroll
                for (int m = 0; m < 4; ++m, rp += rstep) {
                    f32x4 v0 = acc[ai][bj][m][0], v1 = acc[ai][bj][m][1];
                    if (gate) {
                        v0 = v0 * gs + b0; v1 = v1 * gs + b1;
                        const float k_ = 1.f / 255.f; unsigned wx = 0u, wy = 0u;
#pragma unroll
                        for (int j = 0; j < 4; ++j) { const float g0 = fast_rcp(fast_exp2(v0[j]) * k_ + k_) + 0.5f, g1 = fast_rcp(fast_exp2(v1[j]) * k_ + k_) + 0.5f;
                            wx = __builtin_amdgcn_cvt_pk_u8_f32(g0, j, wx); wy = __builtin_amdgcn_cvt_pk_u8_f32(g1, j, wy); }
                        u32x2 w8; w8.x = wx; w8.y = wy;
                        *(u32x2*)rp = w8;
                    } else {
                        v0 = v0 * (sc * out_scale); v1 = v1 * (sc * out_scale);
                    u32x4 w; w.x = pg8::cvt_pk_bf16(v0[0], v0[1]); w.y = pg8::cvt_pk_bf16(v0[2], v0[3]); w.z = pg8::cvt_pk_bf16(v1[0], v1[1]); w.w = pg8::cvt_pk_bf16(v1[2], v1[3]);
                    *(u32x4*)rp = w; }
                }
                rp += 4 * rstep;
            }
        }
    }
};
struct Epi1Map { static constexpr bool PERM = true; unsigned char* ws; LAS const float* gate_bias; float gate_scale, out_scale; int thr, add_lo_hi;
    __device__ __forceinline__ void operator()(const f32x4 (&acc)[2][2][4][2], const pg8::Unit& u, int wr, int wc, int fr, int fq) const {
        pg8::Unit v = u; v.pn += (u.pn >= thr) ? (add_lo_hi >> 16) : (add_lo_hi & 0xffff); Epi1 E{ws, gate_bias, gate_scale, out_scale}; E(acc, v, wr, wc, fr, fq); } };
#define CE_(a, b) do { const unsigned _h = (a) > (b) ? (a) : (b); const unsigned _l = (a) > (b) ? (b) : (a); (a) = _h; (b) = _l; } while (0)
#define SORT16(V) do { CE_(V[0], V[1]); CE_(V[2], V[3]); CE_(V[0], V[2]); CE_(V[1], V[3]); CE_(V[1], V[2]); CE_(V[4], V[5]); CE_(V[6], V[7]); CE_(V[4], V[6]); CE_(V[5], V[7]); CE_(V[5], V[6]); CE_(V[0], V[4]); CE_(V[2], V[6]); CE_(V[2], V[4]); CE_(V[1], V[5]); CE_(V[3], V[7]); CE_(V[3], V[5]); CE_(V[1], V[2]); CE_(V[3], V[4]); CE_(V[5], V[6]); CE_(V[8], V[9]); CE_(V[10], V[11]); CE_(V[8], V[10]); CE_(V[9], V[11]); CE_(V[9], V[10]); CE_(V[12], V[13]); CE_(V[14], V[15]); CE_(V[12], V[14]); CE_(V[13], V[15]); CE_(V[13], V[14]); CE_(V[8], V[12]); CE_(V[10], V[14]); CE_(V[10], V[12]); CE_(V[9], V[13]); CE_(V[11], V[15]); CE_(V[11], V[13]); CE_(V[9], V[10]); CE_(V[11], V[12]); CE_(V[13], V[14]); CE_(V[0], V[8]); CE_(V[4], V[12]); CE_(V[4], V[8]); CE_(V[2], V[10]); CE_(V[6], V[14]); CE_(V[6], V[10]); CE_(V[2], V[4]); CE_(V[6], V[8]); CE_(V[10], V[12]); CE_(V[1], V[9]); CE_(V[5], V[13]); CE_(V[5], V[9]); CE_(V[3], V[11]); CE_(V[7], V[15]); CE_(V[7], V[11]); CE_(V[3], V[5]); CE_(V[7], V[9]); CE_(V[11], V[13]); CE_(V[1], V[2]); CE_(V[3], V[4]); CE_(V[5], V[6]); CE_(V[7], V[8]); CE_(V[9], V[10]); CE_(V[11], V[12]); CE_(V[13], V[14]); } while (0)
#define MERGE16(T, C) do { _Pragma("unroll") for (int _i = 0; _i < 16; ++_i) T[_i] = T[_i] > C[15 - _i] ? T[_i] : C[15 - _i]; CE_(T[0], T[8]); CE_(T[1], T[9]); CE_(T[2], T[10]); CE_(T[3], T[11]); CE_(T[4], T[12]); CE_(T[5], T[13]); CE_(T[6], T[14]); CE_(T[7], T[15]); CE_(T[0], T[4]); CE_(T[1], T[5]); CE_(T[2], T[6]); CE_(T[3], T[7]); CE_(T[8], T[12]); CE_(T[9], T[13]); CE_(T[10], T[14]); CE_(T[11], T[15]); CE_(T[0], T[2]); CE_(T[1], T[3]); CE_(T[4], T[6]); CE_(T[5], T[7]); CE_(T[8], T[10]); CE_(T[9], T[11]); CE_(T[12], T[14]); CE_(T[13], T[15]); CE_(T[0], T[1]); CE_(T[2], T[3]); CE_(T[4], T[5]); CE_(T[6], T[7]); CE_(T[8], T[9]); CE_(T[10], T[11]); CE_(T[12], T[13]); CE_(T[14], T[15]); } while (0)
#define INS16(T, x) do { _Pragma("unroll") for (int _i = 0; _i < 16; ++_i) { const unsigned _hi = T[_i] > (x) ? T[_i] : (x); (x) = T[_i] > (x) ? (x) : T[_i]; T[_i] = _hi; } } while (0)
__device__ __forceinline__ unsigned ord16(unsigned h) { return (h & 0x8000u) ? (~h & 0xffffu) : (h | 0x8000u); }
__device__ __forceinline__ float unord16(unsigned o) { const unsigned h = (o & 0x8000u) ? (o & 0x7fffu) : (~o & 0xffffu); return (float)__builtin_bit_cast(_Float16, (unsigned short)h); }
__device__ __forceinline__ unsigned ord32(float f) { const unsigned u = __builtin_bit_cast(unsigned, f); return (u & 0x80000000u) ? ~u : (u | 0x80000000u); }
__device__ __forceinline__ float unord32(unsigned o) { const unsigned u = (o & 0x80000000u) ? (o & 0x7fffffffu) : ~o; return __builtin_bit_cast(float, u); }

typedef short s16x2_t __attribute__((ext_vector_type(2)));
__device__ __forceinline__ unsigned pkord16(unsigned v) { const s16x2_t m = __builtin_bit_cast(s16x2_t, v) >> 15; return v ^ (__builtin_bit_cast(unsigned, m) | 0x80008000u); }

#define P6_LEVEL1(T, SV) do { _Pragma("unroll") for (int c = 0; c < 8; ++c) { const u32x4 v0 = SV[2 * c], v1 = SV[2 * c + 1]; unsigned C[16]; \
        _Pragma("unroll") for (int e = 0; e < 4; ++e) { const unsigned i0 = (unsigned)(127 - (c * 16 + e * 2)), i1 = (unsigned)(127 - (c * 16 + 8 + e * 2)); const unsigned o0 = pkord16(v0[e]), o1 = pkord16(v1[e]); \
            C[2 * e] = (o0 << 16) | i0; C[2 * e + 1] = (o0 & 0xffff0000u) | (i0 - 1u); C[8 + 2 * e] = (o1 << 16) | i1; C[8 + 2 * e + 1] = (o1 & 0xffff0000u) | (i1 - 1u); } \
        SORT16(C); \
        if (c == 0) { _Pragma("unroll") for (int i = 0; i < 16; ++i) T[i] = C[i]; } else { MERGE16(T, C); } } } while (0)

constexpr int TK_ROW = 528, TK_GRP = 16 * TK_ROW;
struct EpiTopK {
    static constexpr bool PERM = true;
    LAS unsigned char* xl; unsigned* l1k;
    __device__ __forceinline__ void operator()(const f32x4 (&acc)[2][2][4][2], const pg8::Unit& u, int wr, int wc, int fr, int fq) const {
        typedef _Float16 h2 __attribute__((ext_vector_type(2)));
        const int lane = fr + 16 * fq, w = wr * 4 + wc;
        LAS unsigned char* wp = xl + wr * TK_GRP + fr * TK_ROW + (32 * wc + 8 * fq) * 2;
        const LAS unsigned char* rp = xl + (lane >> 5) * TK_GRP + ((lane >> 1) & 15) * TK_ROW + (lane & 1) * 256;
        u32x4 sv[16];
#pragma unroll
        for (int s = 0; s < 8; ++s) {
#pragma unroll
            for (int bj = 0; bj < 2; ++bj) { const f32x4 v0 = acc[s >> 2][bj][s & 3][0], v1 = acc[s >> 2][bj][s & 3][1]; u32x4 q;
                h2 a = {(_Float16)v0[0], (_Float16)v0[1]}, b = {(_Float16)v0[2], (_Float16)v0[3]}, c = {(_Float16)v1[0], (_Float16)v1[1]}, d = {(_Float16)v1[2], (_Float16)v1[3]};
                q.x = __builtin_bit_cast(unsigned, a); q.y = __builtin_bit_cast(unsigned, b); q.z = __builtin_bit_cast(unsigned, c); q.w = __builtin_bit_cast(unsigned, d);
                *(LAS u32x4*)(wp + bj * 256) = q; }
            asm volatile("s_waitcnt lgkmcnt(0)" ::: "memory"); __builtin_amdgcn_s_barrier(); asm volatile("" ::: "memory");
            if (w == s) {
#pragma unroll
                for (int k = 0; k < 16; ++k) sv[k] = *(const LAS u32x4*)(rp + k * 16);
            }
            asm volatile("s_waitcnt lgkmcnt(0)" ::: "memory"); __builtin_amdgcn_s_barrier(); asm volatile("" ::: "memory");
        }
        unsigned T[16];
        P6_LEVEL1(T, sv);
        const size_t row = (size_t)u.pm * 256 + (w >> 2) * 128 + (lane >> 5) * 64 + (w & 3) * 16 + ((lane >> 1) & 15);
        u32x4* op = (u32x4*)(l1k + (row * 16 + u.pn * 2 + (lane & 1)) * 16);
#pragma unroll
        for (int k = 0; k < 4; ++k) { u32x4 o; o.x = T[4 * k]; o.y = T[4 * k + 1]; o.z = T[4 * k + 2]; o.w = T[4 * k + 3]; op[k] = o; }
    }
};
template <bool F16> struct EpiStore {
    static constexpr bool PERM = true;
    unsigned short* O; int ldc;
    __device__ __forceinline__ void operator()(const f32x4 (&acc)[2][2][4][2], const pg8::Unit& u, int wr, int wc, int fr, int fq) const {
        const int row0 = u.pm * 256 + wr * 64 + fr, col0 = u.pn * 256 + wc * 32 + 8 * fq;
#pragma unroll
        for (int ai = 0; ai < 2; ++ai)
#pragma unroll
            for (int m = 0; m < 4; ++m) { unsigned short* rowp = O + (size_t)(row0 + ai * 128 + m * 16) * ldc + col0;
#pragma unroll
                for (int bj = 0; bj < 2; ++bj) { const f32x4 v0 = acc[ai][bj][m][0], v1 = acc[ai][bj][m][1]; u32x4 w;
                    if (F16) {
                        typedef _Float16 h2 __attribute__((ext_vector_type(2)));
                        h2 a = {(_Float16)v0[0], (_Float16)v0[1]}, b = {(_Float16)v0[2], (_Float16)v0[3]}, c = {(_Float16)v1[0], (_Float16)v1[1]}, d = {(_Float16)v1[2], (_Float16)v1[3]};
                        w.x = __builtin_bit_cast(unsigned, a); w.y = __builtin_bit_cast(unsigned, b); w.z = __builtin_bit_cast(unsigned, c); w.w = __builtin_bit_cast(unsigned, d);
                    } else { w.x = pg8::cvt_pk_bf16(v0[0], v0[1]); w.y = pg8::cvt_pk_bf16(v0[2], v0[3]); w.z = pg8::cvt_pk_bf16(v1[0], v1[1]); w.w = pg8::cvt_pk_bf16(v1[2], v1[3]); }
                    *(u32x4*)(rowp + bj * 128) = w; } }
    }
};
template <int PASS> struct EpiUp {
    static constexpr bool PERM = true;
    bf16* merged; const bf16* gates; unsigned char* m8;
    __device__ __forceinline__ void operator()(const f32x4 (&acc)[2][2][4][2], const pg8::Unit& u, int wr, int wc, int fr, int fq) const {
        const int row0 = u.pm * 256 + wr * 64 + fr, col0 = u.pn * 256 + wc * 32 + 8 * fq;
#pragma unroll
        for (int ai = 0; ai < 2; ++ai)
#pragma unroll
            for (int m = 0; m < 4; ++m) { const size_t row = (size_t)(row0 + ai * 128 + m * 16);
#pragma unroll
                for (int bj = 0; bj < 2; ++bj) { const int col = col0 + bj * 128;
                    const u32x2 gw = *(const u32x2*)((const unsigned char*)gates + row * 2048 + PASS * 1024 + col);
                    f32x4 v0 = acc[ai][bj][m][0], v1 = acc[ai][bj][m][1];
                    { const float k_ = 1.f / 255.f; const unsigned g0_ = gw.x, g1_ = gw.y;
                      v0[0] *= (float)(g0_ & 255u) * k_; v0[1] *= (float)((g0_ >> 8) & 255u) * k_; v0[2] *= (float)((g0_ >> 16) & 255u) * k_; v0[3] *= (float)(g0_ >> 24) * k_;
                      v1[0] *= (float)(g1_ & 255u) * k_; v1[1] *= (float)((g1_ >> 8) & 255u) * k_; v1[2] *= (float)((g1_ >> 16) & 255u) * k_; v1[3] *= (float)(g1_ >> 24) * k_; }
                    u32x4* mp = (u32x4*)(merged + row * 1024 + col);
                    if (PASS == 1) { const u32x4 pw = *mp;
                        v0[0] += bflo(pw.x); v0[1] += bfhi(pw.x); v0[2] += bflo(pw.y); v0[3] += bfhi(pw.y);
                        v1[0] += bflo(pw.z); v1[1] += bfhi(pw.z); v1[2] += bflo(pw.w); v1[3] += bfhi(pw.w); }
                    if (PASS == 1) { int w0 = __builtin_amdgcn_cvt_pk_fp8_f32(v0[0], v0[1], 0, false); w0 = __builtin_amdgcn_cvt_pk_fp8_f32(v0[2], v0[3], w0, true);
                        int w1 = __builtin_amdgcn_cvt_pk_fp8_f32(v1[0], v1[1], 0, false); w1 = __builtin_amdgcn_cvt_pk_fp8_f32(v1[2], v1[3], w1, true);
                        u32x2 w8; w8.x = (unsigned)w0; w8.y = (unsigned)w1; *(u32x2*)(m8 + row * 1024 + col) = w8; }
                    else { u32x4 w; w.x = pg8::cvt_pk_bf16(v0[0], v0[1]); w.y = pg8::cvt_pk_bf16(v0[2], v0[3]); w.z = pg8::cvt_pk_bf16(v1[0], v1[1]); w.w = pg8::cvt_pk_bf16(v1[2], v1[3]);
                        *mp = w; } } }
    }
};
struct EpiUpChain {
    static constexpr bool PERM = true;
    const unsigned char* gates; unsigned char* m8;
#define EUC_LOAD(s_) do { const unsigned char* gp_ = gates + (size_t)(row0 + ((s_) >> 2) * 128 + ((s_) & 3) * 16) * 2048 + col0; \
        ga[(s_) & 3][0] = *(const u32x2*)gp_; gb[(s_) & 3][0] = *(const u32x2*)(gp_ + 1024); ga[(s_) & 3][1] = *(const u32x2*)(gp_ + 128); gb[(s_) & 3][1] = *(const u32x2*)(gp_ + 1024 + 128); } while (0)
#define EUC_RATIO(a_, b_, sh_) ((float)(((a_) >> (sh_)) & 255u) * fast_rcp(fmaxf((float)(((b_) >> (sh_)) & 255u), 1.f)))
    __device__ __forceinline__ void mid(f32x4 (&acc)[2][2][4][2], const pg8::Unit& u, int wr, int wc, int fr, int fq) const {
        const int row0 = u.pm * 256 + wr * 64 + fr, col0 = u.pn * 256 + wc * 32 + 8 * fq;
        u32x2 ga[4][2], gb[4][2];
        EUC_LOAD(0); EUC_LOAD(1); EUC_LOAD(2);
#pragma unroll
        for (int s = 0; s < 8; ++s) {
            if (s + 3 < 8) EUC_LOAD(s + 3);
            __builtin_amdgcn_sched_barrier(0);
#pragma unroll
            for (int bj = 0; bj < 2; ++bj) { const unsigned a0 = ga[s & 3][bj].x, a1 = ga[s & 3][bj].y, b0 = gb[s & 3][bj].x, b1 = gb[s & 3][bj].y;
                f32x4 r0, r1;
                r0[0] = EUC_RATIO(a0, b0, 0); r0[1] = EUC_RATIO(a0, b0, 8); r0[2] = EUC_RATIO(a0, b0, 16); r0[3] = EUC_RATIO(a0, b0, 24);
                r1[0] = EUC_RATIO(a1, b1, 0); r1[1] = EUC_RATIO(a1, b1, 8); r1[2] = EUC_RATIO(a1, b1, 16); r1[3] = EUC_RATIO(a1, b1, 24);
                acc[s >> 2][bj][s & 3][0] = acc[s >> 2][bj][s & 3][0] * r0; acc[s >> 2][bj][s & 3][1] = acc[s >> 2][bj][s & 3][1] * r1; }
            __builtin_amdgcn_sched_barrier(0);
        }
    }
#undef EUC_LOAD
#undef EUC_RATIO
    __device__ __forceinline__ void operator()(const f32x4 (&acc)[2][2][4][2], const pg8::Unit& u, int wr, int wc, int fr, int fq) const {
        const int row0 = u.pm * 256 + wr * 64 + fr, col0 = u.pn * 256 + wc * 32 + 8 * fq;
        u32x2 gb[4][2];
#define EUC_LOADB(s_) do { const unsigned char* gp_ = gates + (size_t)(row0 + ((s_) >> 2) * 128 + ((s_) & 3) * 16) * 2048 + 1024 + col0; gb[(s_) & 3][0] = *(const u32x2*)gp_; gb[(s_) & 3][1] = *(const u32x2*)(gp_ + 128); } while (0)
#define EUC_G(b_, sh_) (fmaxf((float)(((b_) >> (sh_)) & 255u), 1.f) * (1.f / 255.f))
        EUC_LOADB(0); EUC_LOADB(1); EUC_LOADB(2);
#pragma unroll
        for (int s = 0; s < 8; ++s) {
            if (s + 3 < 8) EUC_LOADB(s + 3);
            __builtin_amdgcn_sched_barrier(0);
            unsigned char* mp = m8 + (size_t)(row0 + (s >> 2) * 128 + (s & 3) * 16) * 1024 + col0;
#pragma unroll
            for (int bj = 0; bj < 2; ++bj) { const unsigned b0 = gb[s & 3][bj].x, b1 = gb[s & 3][bj].y;
                f32x4 v0 = acc[s >> 2][bj][s & 3][0], v1 = acc[s >> 2][bj][s & 3][1];
                v0[0] *= EUC_G(b0, 0); v0[1] *= EUC_G(b0, 8); v0[2] *= EUC_G(b0, 16); v0[3] *= EUC_G(b0, 24);
                v1[0] *= EUC_G(b1, 0); v1[1] *= EUC_G(b1, 8); v1[2] *= EUC_G(b1, 16); v1[3] *= EUC_G(b1, 24);
                int w0 = __builtin_amdgcn_cvt_pk_fp8_f32(v0[0], v0[1], 0, false); w0 = __builtin_amdgcn_cvt_pk_fp8_f32(v0[2], v0[3], w0, true);
                int w1 = __builtin_amdgcn_cvt_pk_fp8_f32(v1[0], v1[1], 0, false); w1 = __builtin_amdgcn_cvt_pk_fp8_f32(v1[2], v1[3], w1, true);
                u32x2 w8; w8.x = (unsigned)w0; w8.y = (unsigned)w1; *(u32x2*)(mp + bj * 128) = w8; }
            __builtin_amdgcn_sched_barrier(0);
        }
#undef EUC_LOADB
#undef EUC_G
    }
};
struct EpiOut {
    static constexpr bool PERM = false;
    const float* x; float* out; bf16* x1b; float* ssq; float ascale;
    __device__ __forceinline__ void operator()(const f32x4 (&acc)[2][2][4][2], const pg8::Unit& u, int wr, int wc, int fr, int fq) const {
        const int row0 = u.pm * 256 + wr * 64 + fr, col0 = u.pn * 256 + wc * 32 + 4 * fq;
        f32x4 xr[4][4];
#define EO_LOAD(s_) do { const float* xp_ = x + (size_t)(row0 + ((s_) >> 2) * 128 + ((s_) & 3) * 16) * D + col0; \
        xr[(s_) & 3][0] = *(const f32x4*)xp_; xr[(s_) & 3][1] = *(const f32x4*)(xp_ + 16); xr[(s_) & 3][2] = *(const f32x4*)(xp_ + 128); xr[(s_) & 3][3] = *(const f32x4*)(xp_ + 144); } while (0)
        EO_LOAD(0); EO_LOAD(1); EO_LOAD(2);
#pragma unroll
        for (int s = 0; s < 8; ++s) {
            if (s + 3 < 8) EO_LOAD(s + 3);
            __builtin_amdgcn_sched_barrier(0);
            const size_t row = (size_t)(row0 + (s >> 2) * 128 + (s & 3) * 16); const size_t off = row * D + col0; float sm = 0.f;
#pragma unroll
            for (int bj = 0; bj < 2; ++bj)
#pragma unroll
                for (int n = 0; n < 2; ++n) { const f32x4 o = xr[s & 3][bj * 2 + n] + acc[s >> 2][bj][s & 3][n] * ascale;
                    u32x2 w; w.x = pg8::cvt_pk_bf16(o[0], o[1]); w.y = pg8::cvt_pk_bf16(o[2], o[3]); *(u32x2*)(x1b + off + bj * 128 + n * 16) = w;
                    sm += (o[0] * o[0] + o[1] * o[1]) + (o[2] * o[2] + o[3] * o[3]); }
            sm += __shfl_xor(sm, 16); sm += __shfl_xor(sm, 32);
            if (fq == 0) ssq[row * 16 + u.pn * 4 + wc] = sm;
            __builtin_amdgcn_sched_barrier(0);
        }
#undef EO_LOAD
    }
};

__device__ __forceinline__ float xor32f(float x, bool upper) { const unsigned u = __builtin_bit_cast(unsigned, x); auto r = __builtin_amdgcn_permlane32_swap(u, u, false, false);
    return __builtin_bit_cast(float, upper ? r[0] : r[1]); }
constexpr int SWA_KS_STRIDE = 144;
constexpr int SWA_VT_STRIDE = 400;
constexpr int SWA_KS_OFF = 0, SWA_VT_OFF = 192 * SWA_KS_STRIDE;
__device__ __forceinline__ int pi32(int r) { return (r & 19) | ((r & 4) << 1) | ((r & 8) >> 1); }

constexpr int SWA_BUF = 192 * SWA_KS_STRIDE + 64 * SWA_VT_STRIDE;
__device__ __forceinline__ void swa_phase(Ctx& F) {
    unsigned char* ws = F.ws;
    const bf16* QA = (const bf16*)(ws + WS_QA); const bf16* KA = (const bf16*)(ws + WS_KA); const bf16* VA = (const bf16*)(ws + WS_VA);
    bf16* Y = (bf16*)(ws + WS_H);
    const int lane = F.lane, l31 = lane & 31, hh = lane >> 5, wave = F.wave;
    LAS float* GQ = (LAS float*)(F.lds + 2 * SWA_BUF);
    if (F.tid < 64) GQ[F.tid] = F.qgain[F.tid] * F.kgain[F.tid];
    __syncthreads();
    constexpr int NU = BATCH * 32 * 2;
    const int skey = F.tid >> 1, shalf = F.tid & 1, hq = wave >> 1, qh = wave & 1;
    const float sk0 = F.sinks[hq] * LOG2E, sk1 = F.sinks[4 + hq] * LOG2E;
    u32x4 kv[4], vv[4], qv[4];
#define SWA_GLOAD(unit_) do { const int g_ = (unit_) & 1, c_ = ((unit_) >> 1) & 31, b_ = (unit_) >> 6; \
        if (F.tid < 384) { const int p_ = c_ * 64 - 128 + skey; \
            if (p_ >= 0) { const size_t tok_ = (size_t)b_ * SEQ + p_; \
                const u32x4* kp_ = (const u32x4*)(KA + tok_ * 128 + g_ * 64 + shalf * 32); const u32x4* vp_ = (const u32x4*)(VA + tok_ * 128 + g_ * 64 + shalf * 32); \
                _Pragma("unroll") for (int j = 0; j < 4; ++j) { kv[j] = kp_[j]; vv[j] = vp_[j]; } \
            } else { _Pragma("unroll") for (int j = 0; j < 4; ++j) { kv[j] = (u32x4){0u, 0u, 0u, 0u}; vv[j] = (u32x4){0u, 0u, 0u, 0u}; } } } \
        { const size_t tokq_ = (size_t)b_ * SEQ + c_ * 64 + qh * 32 + l31; const u32x4* qp_ = (const u32x4*)(QA + tokq_ * 512 + (g_ * 4 + hq) * 64 + hh * 32); \
          _Pragma("unroll") for (int j = 0; j < 4; ++j) qv[j] = qp_[j]; } } while (0)
    if ((int)F.bid < NU) SWA_GLOAD((int)F.bid);
    int buf = 0;
    for (int unit = F.bid; unit < NU; unit += F.G, buf ^= 1) {
        const int g = unit & 1, c = (unit >> 1) & 31, b = unit >> 6;
        LAS unsigned char* Ks = F.lds + buf * SWA_BUF + SWA_KS_OFF; LAS unsigned char* Vt = F.lds + buf * SWA_BUF + SWA_VT_OFF;
        if (F.tid < 384) {
            const int key = skey, half = shalf;
            float s = 0.f;
#pragma unroll
            for (int j = 0; j < 4; ++j)
#pragma unroll
                for (int e = 0; e < 4; ++e) { const float a = bflo(kv[j][e]), bb = bfhi(kv[j][e]); s += a * a + bb * bb; }
            s += __shfl_xor(s, 1);
            const float r = 1.0f / sqrtf(s * (1.f / 64.f) + RMS_EPS);
#pragma unroll
            for (int j = 0; j < 4; ++j) { u32x4 o;
#pragma unroll
                for (int e = 0; e < 4; ++e) o[e] = pk2(bflo(kv[j][e]) * r, bfhi(kv[j][e]) * r);
                *(LAS u32x4*)(Ks + key * SWA_KS_STRIDE + half * 64 + j * 16) = o; }
#pragma unroll
            for (int j = 0; j < 4; ++j)
#pragma unroll
                for (int e = 0; e < 4; ++e) { const int d = half * 32 + j * 8 + e * 2;
                    *(LAS unsigned short*)(Vt + d * SWA_VT_STRIDE + key * 2) = (unsigned short)(vv[j][e] & 0xffffu);
                    *(LAS unsigned short*)(Vt + (d + 1) * SWA_VT_STRIDE + key * 2) = (unsigned short)(vv[j][e] >> 16); }
        }
        const int head = g * 4 + hq;
        const int qi = qh * 32 + l31;
        const size_t tok = (size_t)b * SEQ + c * 64 + qi;
        bf16x8 qf[4];
        {
            float s = 0.f;
#pragma unroll
            for (int j = 0; j < 4; ++j) {
#pragma unroll
                for (int e = 0; e < 4; ++e) { const float a = bflo(qv[j][e]), bb = bfhi(qv[j][e]); s += a * a + bb * bb; } }
            s += xor32f(s, hh != 0);
            const float r = (1.0f / sqrtf(s * (1.f / 64.f) + RMS_EPS)) * (0.125f * LOG2E);
#pragma unroll
            for (int j = 0; j < 4; ++j) { u32x4 o; const f32x4 ga = *(LAS const f32x4*)(GQ + hh * 32 + j * 8), gb = *(LAS const f32x4*)(GQ + hh * 32 + j * 8 + 4);
                o[0] = pk2(bflo(qv[j][0]) * (ga[0] * r), bfhi(qv[j][0]) * (ga[1] * r)); o[1] = pk2(bflo(qv[j][1]) * (ga[2] * r), bfhi(qv[j][1]) * (ga[3] * r));
                o[2] = pk2(bflo(qv[j][2]) * (gb[0] * r), bfhi(qv[j][2]) * (gb[1] * r)); o[3] = pk2(bflo(qv[j][3]) * (gb[2] * r), bfhi(qv[j][3]) * (gb[3] * r));
                qf[j] = __builtin_bit_cast(bf16x8, o); }
        }
        __builtin_amdgcn_sched_barrier(0);
        { const int nu = unit + (int)F.G; if (nu < NU) SWA_GLOAD(nu); }
        __builtin_amdgcn_sched_barrier(0);
        __syncthreads();
        const float slope = exp2f(-(float)(head + 1)) * LOG2E;
        const float sinkl = g ? sk1 : sk0;
        float mrun = sinkl, lsum = 1.0f;
        f32x16 o0 = {0.f, 0.f, 0.f, 0.f, 0.f, 0.f, 0.f, 0.f, 0.f, 0.f, 0.f, 0.f, 0.f, 0.f, 0.f, 0.f}, o1 = o0;
#pragma unroll 1
        for (int tt = (c < 2 ? 4 - 2 * c : 0); tt < 6; ++tt) {
            f32x16 a = {0.f, 0.f, 0.f, 0.f, 0.f, 0.f, 0.f, 0.f, 0.f, 0.f, 0.f, 0.f, 0.f, 0.f, 0.f, 0.f};
            const LAS unsigned char* kp = Ks + (tt * 32 + pi32(l31)) * SWA_KS_STRIDE + hh * 64;
#pragma unroll
            for (int ks = 0; ks < 4; ++ks) { const bf16x8 kf = *(const LAS bf16x8*)(kp + ks * 16); a = __builtin_amdgcn_mfma_f32_32x32x16_bf16(kf, qf[ks], a, 0, 0, 0); }
            float tmax = -1e30f;
            const float dbase = (float)(qi + 128 - tt * 32 - 8 * hh);
#pragma unroll
            for (int r = 0; r < 16; ++r) { const float dd = dbase - (float)((r & 7) + 16 * (r >> 3)); a[r] = __builtin_fmaf(-slope, __builtin_fabsf(dd), a[r]); tmax = fmaxf(tmax, a[r]); }
            tmax = fmaxf(tmax, xor32f(tmax, hh != 0));
            const float mnew = fmaxf(mrun, tmax);
            const float alpha = fast_exp2(mrun - mnew);
            mrun = mnew;
            float psum = 0.f;
#pragma unroll
            for (int r = 0; r < 16; ++r) { const float p = fast_exp2(a[r] - mnew); a[r] = p; psum += p; }
            psum += xor32f(psum, hh != 0);
            lsum = lsum * alpha + psum;
#pragma unroll
            for (int r = 0; r < 16; ++r) { o0[r] *= alpha; o1[r] *= alpha; }
#pragma unroll
            for (int s = 0; s < 2; ++s) {
                u32x4 pw; pw.x = pg8::cvt_pk_bf16(a[8 * s + 0], a[8 * s + 1]); pw.y = pg8::cvt_pk_bf16(a[8 * s + 2], a[8 * s + 3]);
                pw.z = pg8::cvt_pk_bf16(a[8 * s + 4], a[8 * s + 5]); pw.w = pg8::cvt_pk_bf16(a[8 * s + 6], a[8 * s + 7]);
                const bf16x8 pf = __builtin_bit_cast(bf16x8, pw);
                const int kcol = (tt * 32 + s * 16 + hh * 8) * 2;
                const bf16x8 v0 = *(const LAS bf16x8*)(Vt + l31 * SWA_VT_STRIDE + kcol);
                const bf16x8 v1 = *(const LAS bf16x8*)(Vt + (32 + l31) * SWA_VT_STRIDE + kcol);
                o0 = __builtin_amdgcn_mfma_f32_32x32x16_bf16(v0, pf, o0, 0, 0, 0);
                o1 = __builtin_amdgcn_mfma_f32_32x32x16_bf16(v1, pf, o1, 0, 0, 0);
            }
        }
        const float inv = 1.0f / lsum;
        bf16* yp = Y + tok * 1024 + head * 64 + 4 * hh;
#pragma unroll
        for (int gq = 0; gq < 4; ++gq) {
            u32x2 w; w.x = pg8::cvt_pk_bf16(o0[4 * gq] * inv, o0[4 * gq + 1] * inv); w.y = pg8::cvt_pk_bf16(o0[4 * gq + 2] * inv, o0[4 * gq + 3] * inv);
            *(u32x2*)(yp + 8 * gq) = w;
            u32x2 w1; w1.x = pg8::cvt_pk_bf16(o1[4 * gq] * inv, o1[4 * gq + 1] * inv); w1.y = pg8::cvt_pk_bf16(o1[4 * gq + 2] * inv, o1[4 * gq + 3] * inv);
            *(u32x2*)(yp + 32 + 8 * gq) = w1;
        }
    }
#undef SWA_GLOAD
    __syncthreads();
}

constexpr int SB_KS = 144, SB_VS = 80, SB_LDS_WAVE = 32 * SB_KS + 64 * SB_VS + 32 * SB_KS;
__device__ __forceinline__ void sb_gload(u32x4 (&kr)[4], u32x4 (&vr)[4], const bf16* kg, const bf16* vg, int kt) {
#pragma unroll
    for (int j = 0; j < 4; ++j) kr[j] = *(const u32x4*)(kg + ((size_t)kt * 32 + j * 8) * 512);
#pragma unroll
    for (int j = 0; j < 4; ++j) vr[j] = *(const u32x4*)(vg + (size_t)j * 16 * MTOK + kt * 32);
}
__device__ __forceinline__ void sb_stage(LAS unsigned char* Kl, LAS unsigned char* Vl, const u32x4 (&kr)[4], const u32x4 (&vr)[4], int lane) {
#pragma unroll
    for (int j = 0; j < 4; ++j) *(LAS u32x4*)(Kl + (j * 8 + (lane >> 3)) * SB_KS + (lane & 7) * 16) = kr[j];
#pragma unroll
    for (int j = 0; j < 4; ++j) *(LAS u32x4*)(Vl + (j * 16 + (lane >> 2)) * SB_VS + (lane & 3) * 16) = vr[j];
}
__device__ __forceinline__ void sb_frag(bf16x8 (&kf)[4], bf16x8 (&vf)[2][2], const LAS unsigned char* Kl, const LAS unsigned char* Vl, int l31, int hh) {
#pragma unroll
    for (int ks = 0; ks < 4; ++ks) kf[ks] = *(const LAS bf16x8*)(Kl + pi32(l31) * SB_KS + hh * 64 + ks * 16);
#pragma unroll
    for (int dt = 0; dt < 2; ++dt)
#pragma unroll
        for (int sx = 0; sx < 2; ++sx) vf[dt][sx] = *(const LAS bf16x8*)(Vl + (dt * 32 + l31) * SB_VS + sx * 32 + hh * 16);
}
template <bool DIAG>
__device__ __forceinline__ bool sb_tile(const bf16x8 (&kf)[4], const bf16x8 (&vf)[2][2], const bf16x8 (&qf)[4], f32x16& o0, f32x16& o1, float& carry, int kt, int tq, int hh) {
    f32x16 a = {0.f, 0.f, 0.f, 0.f, 0.f, 0.f, 0.f, 0.f, 0.f, 0.f, 0.f, 0.f, 0.f, 0.f, 0.f, 0.f};
#pragma unroll
    for (int ks = 0; ks < 4; ++ks) a = __builtin_amdgcn_mfma_f32_32x32x16_bf16(kf[ks], qf[ks], a, 0, 0, 0);
    float L[16];
    const int kb0 = kt * 32 + 8 * hh;
    typedef float f2_t __attribute__((ext_vector_type(2)));
#pragma unroll
    for (int rp = 0; rp < 8; ++rp) { const int r0 = 2 * rp, r1 = r0 + 1; const float y0 = a[r0], y1 = a[r1];
        const f2_t t = {fast_exp2(-fabsf(y0)), fast_exp2(-fabsf(y1))};
        f2_t pl = t * 0.05994558706879616f + (-0.22771264612674713f); pl = pl * t + 0.44227418303489685f; pl = pl * t + (-0.7170639038085938f); pl = pl * t + 1.4426156282424927f; pl = pl * t;
        const f2_t mx = {__builtin_amdgcn_fmed3f(y0, 0.f, 3.0e38f), __builtin_amdgcn_fmed3f(y1, 0.f, 3.0e38f)};
        const f2_t sp = mx + pl;
        const int key0 = kb0 + (r0 & 7) + 16 * (r0 >> 3), key1 = kb0 + (r1 & 7) + 16 * (r1 >> 3);
        L[r0] = (!DIAG || key0 < tq) ? -sp.x : 0.f; L[r1] = (!DIAG || key1 < tq) ? -sp.y : 0.f; }
#pragma unroll
    for (int r = 6; r >= 0; --r) { L[r] += L[r + 1]; L[8 + r] += L[8 + r + 1]; }
    const float sA = L[0], sB = L[8];
    const float pA = xor32f(sA, hh != 0), pB = xor32f(sB, hh != 0);
    const float offA = (hh == 0) ? (pA + sB + pB) : (pB + sB);
    const float offB = (hh == 0) ? pB : 0.f;
    const float cA = offA + carry, cB = offB + carry;
    float p[16];
#pragma unroll
    for (int rp = 0; rp < 8; ++rp) { const int r0 = 2 * rp, r1 = r0 + 1; const float cc_ = rp < 4 ? cA : cB;
        const f2_t av = {a[r0], a[r1]}, lv = {L[r0], L[r1]}, cv = {cc_, cc_}; const f2_t e = (av + lv) + cv;
        const int key0 = kb0 + (r0 & 7) + 16 * (r0 >> 3), key1 = kb0 + (r1 & 7) + 16 * (r1 >> 3);
        p[r0] = (!DIAG || key0 < tq) ? fast_exp2(e.x) : 0.f; p[r1] = (!DIAG || key1 < tq) ? fast_exp2(e.y) : 0.f; }
    carry += sA + sB + pA + pB;
#pragma unroll
    for (int s = 0; s < 2; ++s) {
        u32x4 pw; pw.x = pg8::cvt_pk_bf16(p[8 * s + 0], p[8 * s + 1]); pw.y = pg8::cvt_pk_bf16(p[8 * s + 2], p[8 * s + 3]);
        pw.z = pg8::cvt_pk_bf16(p[8 * s + 4], p[8 * s + 5]); pw.w = pg8::cvt_pk_bf16(p[8 * s + 6], p[8 * s + 7]);
        const bf16x8 pf = __builtin_bit_cast(bf16x8, pw);
        o0 = __builtin_amdgcn_mfma_f32_32x32x16_bf16(vf[0][s], pf, o0, 0, 0, 0);
        o1 = __builtin_amdgcn_mfma_f32_32x32x16_bf16(vf[1][s], pf, o1, 0, 0, 0);
    }
    return __all(carry < SB_EXIT);
}
__device__ __forceinline__ void sb_phase(Ctx& F) {
    unsigned char* ws = F.ws;
    const bf16* QB = (const bf16*)(ws + WS_QB); const bf16* KB = (const bf16*)(ws + WS_KB); const bf16* VBT = (const bf16*)(ws + WS_VBT);
    bf16* Y = (bf16*)(ws + WS_H);
    const int lane = F.lane, l31 = lane & 31, hh = lane >> 5;
    const int gw = F.bid * 8 + F.wave, NGW = F.G * 8;
    LAS unsigned char* Kl = F.lds + F.wave * SB_LDS_WAVE; LAS unsigned char* Vl = Kl + 32 * SB_KS; LAS unsigned char* Ql = Vl + 64 * SB_VS;
#define SB_ITEM2(it_, qt_, hd_, b_, tq_, tok_, kg_, vg_, rq_) const int qt_ = 63 - ((it_) & 63), hd_ = ((it_) >> 6) & 7, b_ = (it_) >> 9; const int tq_ = qt_ * 32 + l31; \
        const size_t tok_ = (size_t)b_ * SEQ + tq_; const bf16* kg_ = KB + ((size_t)b_ * SEQ + (lane >> 3)) * 512 + hd_ * 64 + (lane & 7) * 8; const bf16* vg_ = VBT + (size_t)(hd_ * 64 + (lane >> 2)) * MTOK + (size_t)b_ * SEQ + (lane & 3) * 8; const size_t rq_ = (size_t)b_ * SEQ + qt_ * 32 + (lane >> 3)
    const int nitems = BATCH * 8 * 64;
    const bool xmap = (F.G == 256) && (nitems == 256 * 64);
    const int xcd = F.bid & 7, widx = F.bid >> 3;
#define SB_SEQ(k_) (xmap ? (((xcd + 8 * ((k_) * 4 + (widx >> 3))) * 64) + (widx & 7) * 8 + F.wave) : (gw + (k_) * NGW))
    const int nseq = xmap ? 8 : (nitems - gw + NGW - 1) / NGW;
    u32x4 qn[4], kn[4], vn[4];
    if (nseq > 0) { SB_ITEM2(SB_SEQ(0), qt0, hd0, b0, tq0, tok0, kg0, vg0, rq0);
#pragma unroll
        for (int j = 0; j < 4; ++j) qn[j] = *(const u32x4*)(QB + (rq0 + j * 8) * 512 + hd0 * 64 + (lane & 7) * 8);
        sb_gload(kn, vn, kg0, vg0, qt0); (void)tq0; (void)tok0; }
    for (int sq = 0; sq < nseq; ++sq) {
        const int item = SB_SEQ(sq);
        SB_ITEM2(item, qt, hd, b, tq, tok, kg, vg, rq);
        bf16x8 qf[4], kf[4], vf[2][2]; u32x4 kx[4], vx[4];
        asm volatile("" ::: "memory");
        sb_stage(Kl, Vl, kn, vn, lane);
#pragma unroll
        for (int j = 0; j < 4; ++j) *(LAS u32x4*)(Ql + (j * 8 + (lane >> 3)) * SB_KS + (lane & 7) * 16) = qn[j];
        asm volatile("" ::: "memory");
#pragma unroll
        for (int j = 0; j < 4; ++j) qf[j] = *(const LAS bf16x8*)(Ql + l31 * SB_KS + hh * 64 + j * 16);
        asm volatile("" ::: "memory");
        { const int nitem = (sq + 1 < nseq) ? SB_SEQ(sq + 1) : item; SB_ITEM2(nitem, qtn, hdn, bn, tqn, tokn, kgn, vgn, rqn);
#pragma unroll
          for (int j = 0; j < 4; ++j) qn[j] = *(const u32x4*)(QB + (rqn + j * 8) * 512 + hdn * 64 + (lane & 7) * 8);
          sb_gload(kn, vn, kgn, vgn, qtn); (void)tqn; (void)tokn; }
        f32x16 o0 = {0.f, 0.f, 0.f, 0.f, 0.f, 0.f, 0.f, 0.f, 0.f, 0.f, 0.f, 0.f, 0.f, 0.f, 0.f, 0.f}, o1 = o0;
        float carry = 0.f;
        {
            int kt = qt;
            sb_gload(kx, vx, kg, vg, kt > 0 ? kt - 1 : 0);
            asm volatile("" ::: "memory");
            sb_frag(kf, vf, Kl, Vl, l31, hh);
            asm volatile("" ::: "memory");
            __builtin_amdgcn_sched_barrier(0);
            if (!(sb_tile<true>(kf, vf, qf, o0, o1, carry, kt, tq, hh) || kt == 0)) {
                --kt;
                for (;;) {
                    sb_stage(Kl, Vl, kx, vx, lane);
                    asm volatile("" ::: "memory");
                    __builtin_amdgcn_sched_barrier(0);
                    sb_gload(kx, vx, kg, vg, kt > 0 ? kt - 1 : 0);
                    sb_frag(kf, vf, Kl, Vl, l31, hh);
                    asm volatile("" ::: "memory");
                    __builtin_amdgcn_sched_barrier(0);
                    if (sb_tile<false>(kf, vf, qf, o0, o1, carry, kt, tq, hh) || kt == 0) break;
                    --kt;
                }
            }
        }
        asm volatile("" ::: "memory");
#pragma unroll
        for (int gq = 0; gq < 4; ++gq) {
            u32x2 w; w.x = pg8::cvt_pk_bf16(o0[4 * gq], o0[4 * gq + 1]); w.y = pg8::cvt_pk_bf16(o0[4 * gq + 2], o0[4 * gq + 3]);
            *(LAS u32x2*)(Ql + l31 * SB_KS + (8 * gq + 4 * hh) * 2) = w;
            u32x2 w1; w1.x = pg8::cvt_pk_bf16(o1[4 * gq], o1[4 * gq + 1]); w1.y = pg8::cvt_pk_bf16(o1[4 * gq + 2], o1[4 * gq + 3]);
            *(LAS u32x2*)(Ql + l31 * SB_KS + (32 + 8 * gq + 4 * hh) * 2) = w1;
        }
        asm volatile("" ::: "memory");
#pragma unroll
        for (int j = 0; j < 4; ++j) { const u32x4 ov = *(const LAS u32x4*)(Ql + (j * 8 + (lane >> 3)) * SB_KS + (lane & 7) * 16);
            *(u32x4*)(Y + (rq + j * 8) * 1024 + 512 + hd * 64 + (lane & 7) * 8) = ov; }
        asm volatile("" ::: "memory");
        (void)tok;
    }
#undef SB_ITEM2
#undef SB_SEQ
}

#define P6_IDX(T, off_) do { _Pragma("unroll") for (int i = 0; i < 4; ++i) { const unsigned w = (127u - (T[4 * i] & 127u)) | ((127u - (T[4 * i + 1] & 127u)) << 8) | ((127u - (T[4 * i + 2] & 127u)) << 16) | ((127u - (T[4 * i + 3] & 127u)) << 24); \
        *(LAS unsigned*)(idxl + (off_) + lane * 16 + i * 4) = w; } } while (0)
__device__ __forceinline__ int lane_id() { return (int)__builtin_amdgcn_mbcnt_hi(~0u, __builtin_amdgcn_mbcnt_lo(~0u, 0u)); }
__device__ __forceinline__ void peer_select_phase(Ctx& F) {
    unsigned char* ws = F.ws;
    const unsigned* L1K = (const unsigned*)(ws + WS_GATES);
    const bf16* X1B = (const bf16*)(ws + WS_H); const float* SSQ = (const float*)(ws + WS_SSQ);
    unsigned short* PE = (unsigned short*)(ws + WS_PE); float* PG = (float*)(ws + WS_PG); float* SXR = (float*)(ws + WS_SXR); float* RSTD = (float*)(ws + WS_RSTD);
    const int lane = lane_id(), wave = F.wave;
    LAS unsigned char* idxl = F.lds + wave * 2048;
    const int gw = F.bid * 8 + F.wave, NGW = F.G * 8, NGRP = MTOK / 8;
    const int tl = lane >> 4, list = lane & 15, p = lane & 1, head = list >> 1;
#define P6_LOADT(TQ, tok_) do { const u32x4* sp_ = (const u32x4*)(L1K + ((size_t)(tok_) * 16 + list) * 16); TQ[0] = sp_[0]; TQ[1] = sp_[1]; TQ[2] = sp_[2]; TQ[3] = sp_[3]; } while (0)
    u32x4 tqA[4], tqB[4];
    if (gw < NGRP) { P6_LOADT(tqA, gw * 8 + tl); P6_LOADT(tqB, gw * 8 + 4 + tl); }
    for (int grp = gw; grp < NGRP; grp += NGW) {
        const int t0 = grp * 8, tokL = t0 + 4 * p + tl;
        unsigned TA[16], TB[16];
#pragma unroll
        for (int i = 0; i < 4; ++i) { TA[4 * i] = tqA[i].x; TA[4 * i + 1] = tqA[i].y; TA[4 * i + 2] = tqA[i].z; TA[4 * i + 3] = tqA[i].w; TB[4 * i] = tqB[i].x; TB[4 * i + 1] = tqB[i].y; TB[4 * i + 2] = tqB[i].z; TB[4 * i + 3] = tqB[i].w; }
        { const int gn = (grp + NGW < NGRP) ? grp + NGW : grp; P6_LOADT(tqA, gn * 8 + tl); P6_LOADT(tqB, gn * 8 + 4 + tl); }
        P6_IDX(TA, 0);
        P6_IDX(TB, 1024);
        __builtin_amdgcn_sched_barrier(0);
        f32x4 sq0, sq1, sq2, sq3;
        { const f32x4* sp = (const f32x4*)(SSQ + (size_t)tokL * 16); sq0 = sp[0]; sq1 = sp[1]; sq2 = sp[2]; sq3 = sp[3]; }
        __builtin_amdgcn_sched_barrier(0);
        float va[16], vb[16];
#pragma unroll
        for (int i = 0; i < 16; ++i) { const unsigned send = p ? TA[i] : TB[i]; const unsigned recv = (unsigned)__builtin_amdgcn_update_dpp(0, (int)send, 0xB1, 0xf, 0xf, true);
            const unsigned ka = p ? recv : TA[i], kb = p ? TB[i] : recv;
            va[i] = unord16(ka >> 16); vb[i] = unord16(kb >> 16); }
#define CAND(i, j) ((ord32(va[i] + vb[j]) & 0xffffff00u) | (unsigned)(255 - ((i) * 16 + (j))))
        unsigned R[16];
#pragma unroll
        for (int j = 0; j < 16; ++j) R[j] = CAND(0, j);
        { unsigned C[16];
#pragma unroll
          for (int j = 0; j < 8; ++j) C[j] = CAND(1, j);
#pragma unroll
          for (int j = 0; j < 5; ++j) C[8 + j] = CAND(2, j);
#pragma unroll
          for (int j = 0; j < 3; ++j) C[13 + j] = CAND(4, j);
          SORT16(C); MERGE16(R, C);
#pragma unroll
          for (int j = 0; j < 4; ++j) C[j] = CAND(3, j);
          C[4] = CAND(5, 0); C[5] = CAND(5, 1); C[6] = CAND(6, 0); C[7] = CAND(6, 1); C[8] = CAND(7, 0); C[9] = CAND(7, 1);
          C[10] = CAND(8, 0); C[11] = CAND(9, 0); C[12] = CAND(10, 0); C[13] = CAND(11, 0); C[14] = CAND(12, 0); C[15] = CAND(13, 0);
          SORT16(C); MERGE16(R, C);
          unsigned x14 = CAND(14, 0); INS16(R, x14); unsigned x15 = CAND(15, 0); INS16(R, x15); }
#undef CAND
        __builtin_amdgcn_sched_barrier(0);
        __builtin_amdgcn_sched_barrier(0);
        const float ssq = ((sq0.x + sq0.y) + (sq0.z + sq0.w)) + ((sq1.x + sq1.y) + (sq1.z + sq1.w)) + ((sq2.x + sq2.y) + (sq2.z + sq2.w)) + ((sq3.x + sq3.y) + (sq3.z + sq3.w));
        const float rms = 1.0f / sqrtf(ssq * (1.f / D) + RMS_EPS);
        {
            const float s0 = unord32(R[0] & 0xffffff00u);
            float gsum = 0.f; float gv[16];
#pragma unroll
            for (int k = 0; k < 16; ++k) { gv[k] = fast_exp2((unord32(R[k] & 0xffffff00u) - s0) * rms * LOG2E); gsum += gv[k]; }
            const float ginv = 1.0f / gsum;
            LAS const unsigned char* la = idxl + p * 1024 + (lane & ~1) * 16; LAS const unsigned char* lb = idxl + p * 1024 + (lane | 1) * 16;
            unsigned ex[16];
#pragma unroll
            for (int k = 0; k < 16; ++k) { const int pos = 255 - (int)(R[k] & 255u); ex[k] = (unsigned)la[pos >> 4] * 128u + (unsigned)lb[pos & 15]; }
            u32x4* pe = (u32x4*)(PE + (size_t)tokL * 128 + head * 16); f32x4* pg = (f32x4*)(PG + (size_t)tokL * 128 + head * 16);
#pragma unroll
            for (int k = 0; k < 2; ++k) { u32x4 w; w.x = ex[8 * k] | (ex[8 * k + 1] << 16); w.y = ex[8 * k + 2] | (ex[8 * k + 3] << 16); w.z = ex[8 * k + 4] | (ex[8 * k + 5] << 16); w.w = ex[8 * k + 6] | (ex[8 * k + 7] << 16); pe[k] = w; }
#pragma unroll
            for (int k = 0; k < 4; ++k) { f32x4 g; g.x = gv[4 * k] * ginv; g.y = gv[4 * k + 1] * ginv; g.z = gv[4 * k + 2] * ginv; g.w = gv[4 * k + 3] * ginv; pg[k] = g; }
        }
        if ((lane & 14) == 0) { RSTD[tokL] = rms; SXR[tokL] = 8.f / 127.f; }
    }
}

#define PA_LOAD_META(ID, XC, RS, tk) do { ID = PE[(size_t)(tk) * 64 + lane]; XC = *(const unsigned*)((const unsigned char*)X1B + (size_t)(tk) * 2048 + x * 256 + lane * 4); RS = RSTD[(size_t)(tk) + vzero]; } while (0)
#define PX_BC8(dst_, src_, qp_, lo_) do { const int q_ = __builtin_amdgcn_update_dpp(0, (int)(src_), qp_, 0xf, 0xf, true); \
        dst_ = (lo_) ? (unsigned)__builtin_amdgcn_update_dpp(q_, q_, 0x114, 0xf, 0xa, false) : (unsigned)__builtin_amdgcn_update_dpp(q_, q_, 0x104, 0xf, 0x5, false); } while (0)
#define PA_ISSUE2(R, ID, k_, qp_, lo_) do { unsigned w_; PX_BC8(w_, ID, qp_, lo_); \
        R[2 * (k_)] = *(const u32x4*)(tabu + ((w_ & 0xffffu) * 128u + coff)); R[2 * (k_) + 1] = *(const u32x4*)(tabu + ((w_ >> 16) * 128u + coff)); } while (0)
#define PA_ISSUE(R, ID) do { PA_ISSUE2(R, ID, 0, 0x00, true); PA_ISSUE2(R, ID, 1, 0x55, true); PA_ISSUE2(R, ID, 2, 0xAA, true); PA_ISSUE2(R, ID, 3, 0xFF, true); \
        PA_ISSUE2(R, ID, 4, 0x00, false); PA_ISSUE2(R, ID, 5, 0x55, false); PA_ISSUE2(R, ID, 6, 0xAA, false); PA_ISSUE2(R, ID, 7, 0xFF, false); } while (0)
#define PA_XS(XS, XC, RS) do { const float s_ = (RS) * (127.f / 8.f); \
        const int q0_ = (int)rintf(__builtin_amdgcn_fmed3f(bflo(XC) * s_, -127.f, 127.f)), q1_ = (int)rintf(__builtin_amdgcn_fmed3f(bfhi(XC) * s_, -127.f, 127.f)); \
        const unsigned pk_ = (unsigned)(q0_ & 255) | ((unsigned)(q1_ & 255) << 8); const unsigned pt_ = (unsigned)__builtin_amdgcn_update_dpp(0, (int)pk_, 0xB1, 0xf, 0xf, true); \
        const unsigned w_ = (lane & 1) ? (pt_ | (pk_ << 16)) : (pk_ | (pt_ << 16)); \
        XS.x = (unsigned)__builtin_amdgcn_ds_bpermute(c * 32, (int)w_); XS.y = (unsigned)__builtin_amdgcn_ds_bpermute(c * 32 + 8, (int)w_); \
        XS.z = (unsigned)__builtin_amdgcn_ds_bpermute(c * 32 + 16, (int)w_); XS.w = (unsigned)__builtin_amdgcn_ds_bpermute(c * 32 + 24, (int)w_); } while (0)
#define PA_DOT(d, R, XS) do { \
        _Pragma("unroll") for (int i = 0; i < 16; ++i) { const u32x4 u = R[i]; \
            int a = __builtin_amdgcn_sdot4((int)u.x, (int)XS.x, 0, false); a = __builtin_amdgcn_sdot4((int)u.y, (int)XS.y, a, false); \
            a = __builtin_amdgcn_sdot4((int)u.z, (int)XS.z, a, false); a = __builtin_amdgcn_sdot4((int)u.w, (int)XS.w, a, false); d[i] = a; } } while (0)
#define PA_REDUCE_STORE(d, tk) do { \
        _Pragma("unroll") for (int i = 0; i < 8; ++i) { const int a = d[i], b = d[i + 8]; const int R_ = (lane & 4) ? b : a, S_ = (lane & 4) ? a : b; \
            d[i] = R_ + (int)__builtin_amdgcn_update_dpp(0u, (unsigned)S_, 0x141, 0xf, 0xf, true); } \
        _Pragma("unroll") for (int i = 0; i < 4; ++i) { const int a = d[i], b = d[i + 4]; const int R_ = (lane & 2) ? b : a, S_ = (lane & 2) ? a : b; \
            d[i] = R_ + (int)__builtin_amdgcn_update_dpp(0u, (unsigned)S_, 0x4E, 0xf, 0xf, true); } \
        _Pragma("unroll") for (int i = 0; i < 2; ++i) { const int a = d[i], b = d[i + 2]; const int R_ = (lane & 1) ? b : a, S_ = (lane & 1) ? a : b; \
            d[i] = R_ + (int)__builtin_amdgcn_update_dpp(0u, (unsigned)S_, 0xB1, 0xf, 0xf, true); } \
          \
        ((unsigned*)PD)[((size_t)x * MTOK + (tk)) * 64 + lane] = (unsigned)(((d[0] + 32) >> 6) & 0xffff) | ((unsigned)((d[1] + 32) >> 6) << 16); } while (0)
__device__ __forceinline__ void peer_dot_phase(Ctx& F, size_t tab_off = WS_UT, size_t pd_off = WS_PD) {
    unsigned char* ws = F.ws;
    const unsigned char* UT8 = ws + tab_off; const bf16* X1B = (const bf16*)(ws + WS_H); const float* RSTD = (const float*)(ws + WS_RSTD); const unsigned* PE = (const unsigned*)(ws + WS_PE); int* PD = (int*)(ws + pd_off);
    const int lane = lane_id(), g = lane >> 3, c = lane & 7;
    int vzero; asm volatile("v_mov_b32 %0, 0" : "=v"(vzero));

    const int x = F.bid & 7, wq = (F.bid >> 3) * 8 + F.wave, nwq = (F.G >> 3) * 8;
    const unsigned char* tabu = UT8 + (size_t)x * NEXP * 128; const unsigned coff = (unsigned)c * 16u;
    const int cnt = (MTOK - wq + nwq - 1) / nwq;
    if (cnt <= 0) return;
#define TOKN(n) (wq + ((n) < cnt ? (n) : cnt - 1) * nwq)
    const int bpa = (lane & ~7) * 4;
    unsigned idA, idB; u32x4 rA[16], rB[16], xsA, xsB; unsigned xcA, xcB; float rsA, rsB;
    PA_LOAD_META(idA, xcA, rsA, TOKN(0)); PA_LOAD_META(idB, xcB, rsB, TOKN(1)); PA_ISSUE(rA, idA); PA_ISSUE(rB, idB); PA_XS(xsA, xcA, rsA); PA_XS(xsB, xcB, rsB);
    PA_LOAD_META(idA, xcA, rsA, TOKN(2)); PA_LOAD_META(idB, xcB, rsB, TOKN(3));
#define PA_STEP(R, XS, ID, XC, RS, n_, guard) do { int d[16]; PA_DOT(d, R, XS); \
        __builtin_amdgcn_sched_barrier(0); \
        PA_ISSUE(R, ID); PA_XS(XS, XC, RS); PA_LOAD_META(ID, XC, RS, TOKN((n_) + 4)); \
        __builtin_amdgcn_sched_barrier(0); \
        if (guard) PA_REDUCE_STORE(d, TOKN(n_)); \
        __builtin_amdgcn_sched_barrier(0); } while (0)
    int n = 0;
    for (; n + 8 <= cnt; n += 8) {
        PA_STEP(rA, xsA, idA, xcA, rsA, n, true); PA_STEP(rB, xsB, idB, xcB, rsB, n + 1, true); PA_STEP(rA, xsA, idA, xcA, rsA, n + 2, true); PA_STEP(rB, xsB, idB, xcB, rsB, n + 3, true);
        PA_STEP(rA, xsA, idA, xcA, rsA, n + 4, true); PA_STEP(rB, xsB, idB, xcB, rsB, n + 5, true); PA_STEP(rA, xsA, idA, xcA, rsA, n + 6, true); PA_STEP(rB, xsB, idB, xcB, rsB, n + 7, true);
    }
    for (; n < cnt; n += 2) { PA_STEP(rA, xsA, idA, xcA, rsA, n, true); PA_STEP(rB, xsB, idB, xcB, rsB, n + 1, n + 1 < cnt); }
#undef PA_STEP
#undef TOKN
}

__device__ __forceinline__ void peer_coef_phase(Ctx& F) {
    unsigned char* ws = F.ws;
    const unsigned* PD = (const unsigned*)(ws + WS_PD); const unsigned* PE = (const unsigned*)(ws + WS_PE); const float* PG = (const float*)(ws + WS_PG);
    const float* SU = (const float*)(ws + WS_SU); const float* SV = (const float*)(ws + WS_SV); const float* SXR = (const float*)(ws + WS_SXR);
    unsigned short* PC8 = (unsigned short*)(ws + WS_PC); float* SCT = (float*)(ws + WS_SCT);
    const int gw = F.bid * 8 + F.wave, NGW = F.G * 8, lane = lane_id();
    for (int b = gw; b < MTOK / 8; b += NGW) {
        const int t0 = b * 8;
        unsigned pd[8][8], ev[8]; f32x2 gv[8]; float sxr[8];
#pragma unroll
        for (int j = 0; j < 8; ++j) ev[j] = PE[(size_t)(t0 + j) * 64 + lane];
        __builtin_amdgcn_sched_barrier(0);
#pragma unroll
        for (int j = 0; j < 8; ++j) {
#pragma unroll
            for (int x = 0; x < 8; ++x) pd[j][x] = PD[((size_t)x * MTOK + t0 + j) * 64 + lane];
            gv[j] = *(const f32x2*)(PG + (size_t)(t0 + j) * 128 + 2 * lane); sxr[j] = SXR[t0 + j];
        }
        __builtin_amdgcn_sched_barrier(0);
        float su0[8], su1[8], sv0[8], sv1[8];
#pragma unroll
        for (int j = 0; j < 8; ++j) { const unsigned e0 = ev[j] & 0xffffu, e1 = ev[j] >> 16; su0[j] = SU[e0]; su1[j] = SU[e1]; sv0[j] = SV[e0]; sv1[j] = SV[e1]; }
        __builtin_amdgcn_sched_barrier(0);
#pragma unroll
        for (int j = 0; j < 8; ++j) {
            int s0 = 0, s1 = 0;
#pragma unroll
            for (int x = 0; x < 8; ++x) { const unsigned v = pd[j][x]; s0 += (int)(short)(v & 0xffffu); s1 += (int)v >> 16; }
            s0 <<= 6; s1 <<= 6;
            const float c0 = gv[j].x * gelu_erf((float)s0 * su0[j] * sxr[j]) * sv0[j], c1 = gv[j].y * gelu_erf((float)s1 * su1[j] * sxr[j]) * sv1[j];
            float m = fmaxf(fabsf(c0), fabsf(c1));
#pragma unroll
            for (int o = 1; o < 64; o <<= 1) m = fmaxf(m, __shfl_xor(m, o));
            const float sc = m > 0.f ? m * (1.f / 127.f) : 1.f, ic = 1.f / sc;
            const int q0 = (int)rintf(c0 * ic), q1 = (int)rintf(c1 * ic);
            PC8[(size_t)(t0 + j) * 64 + lane] = (unsigned short)((q0 & 255) | ((q1 & 255) << 8));
            if (lane == 0) SCT[t0 + j] = sc;
        }
    }
}

#define PB_LOAD_ID(ID, tk) do { ID = PE[(size_t)(tk) * 64 + lane]; } while (0)
#define PB_LOAD_CC(CC, XD, tk) do { CC = *((lane < 32) ? (const unsigned*)(PC8 + (size_t)(tk) * 128 + lane * 4) : (const unsigned*)(SCT + (tk))); \
        XD = *(const unsigned*)((const unsigned char*)X1B + (size_t)(tk) * 2048 + x * 256 + xdo); } while (0)
#define PB_BC8(dst_, src_, qp_, lo_) do { const int q_ = __builtin_amdgcn_update_dpp(0, (int)(src_), qp_, 0xf, 0xf, true); \
        dst_ = (lo_) ? (unsigned)__builtin_amdgcn_update_dpp(q_, q_, 0x114, 0xf, 0xa, false) : (unsigned)__builtin_amdgcn_update_dpp(q_, q_, 0x104, 0xf, 0x5, false); } while (0)
#define PB_ISSUE2(R, ID, k_, qp_, lo_) do { unsigned w_; PB_BC8(w_, ID, qp_, lo_); \
        R[2 * (k_)] = *(const u32x4*)(tabu + ((w_ & 0xffffu) * 128u + coff)); R[2 * (k_) + 1] = *(const u32x4*)(tabu + ((w_ >> 16) * 128u + coff)); } while (0)
#define PB_ISSUE(R, ID) do { PB_ISSUE2(R, ID, 0, 0x00, true); PB_ISSUE2(R, ID, 1, 0x55, true); PB_ISSUE2(R, ID, 2, 0xAA, true); PB_ISSUE2(R, ID, 3, 0xFF, true); \
        PB_ISSUE2(R, ID, 4, 0x00, false); PB_ISSUE2(R, ID, 5, 0x55, false); PB_ISSUE2(R, ID, 6, 0xAA, false); PB_ISSUE2(R, ID, 7, 0xFF, false); } while (0)
#define PB_BLK(R, q_, CQ) do { _Pragma("unroll") for (int j_ = 0; j_ < 4; ++j_) { const unsigned a0_ = R[4 * (q_)][j_], a1_ = R[4 * (q_) + 1][j_], a2_ = R[4 * (q_) + 2][j_], a3_ = R[4 * (q_) + 3][j_]; \
            const unsigned l01_ = __builtin_amdgcn_perm(a1_, a0_, 0x05010400u), h01_ = __builtin_amdgcn_perm(a1_, a0_, 0x07030602u), l23_ = __builtin_amdgcn_perm(a3_, a2_, 0x05010400u), h23_ = __builtin_amdgcn_perm(a3_, a2_, 0x07030602u); \
            acc[4 * j_]     = __builtin_amdgcn_sdot4((int)__builtin_amdgcn_perm(l23_, l01_, 0x05040100u), (int)(CQ), acc[4 * j_], false); \
            acc[4 * j_ + 1] = __builtin_amdgcn_sdot4((int)__builtin_amdgcn_perm(l23_, l01_, 0x07060302u), (int)(CQ), acc[4 * j_ + 1], false); \
            acc[4 * j_ + 2] = __builtin_amdgcn_sdot4((int)__builtin_amdgcn_perm(h23_, h01_, 0x05040100u), (int)(CQ), acc[4 * j_ + 2], false); \
            acc[4 * j_ + 3] = __builtin_amdgcn_sdot4((int)__builtin_amdgcn_perm(h23_, h01_, 0x07060302u), (int)(CQ), acc[4 * j_ + 3], false); } } while (0)
__device__ __forceinline__ void peer_axpy_phase(Ctx& F) {
    unsigned char* ws = F.ws;
    const unsigned char* VT8 = ws + WS_VT; const unsigned* PE = (const unsigned*)(ws + WS_PE); const unsigned char* PC8 = ws + WS_PC; const float* SCT = (const float*)(ws + WS_SCT);
    const bf16* X1B = (const bf16*)(ws + WS_H);
    const int lane = lane_id(), g = lane >> 3, c = lane & 7;
    const int x = F.bid & 7, wq = (F.bid >> 3) * 8 + F.wave, nwq = (F.G >> 3) * 8;
    const unsigned char* tabu = VT8 + (size_t)x * NEXP * 128; const unsigned coff = (unsigned)c * 16u;
    LAS unsigned char* wsm = F.lds + F.wave * 256;
    const int k0 = ((lane >> 3) & 1) * 8 + ((lane >> 4) & 1) * 4 + ((lane >> 5) & 1) * 2;
    const unsigned xdo = (unsigned)((16 * c + k0) * 2);
    const size_t ochan = (size_t)(x * 128 + 16 * c + k0);
    const bool b3 = (lane & 8) != 0;
    const int cnt = (MTOK - wq + nwq - 1) / nwq;
    if (cnt <= 0) return;
#define TOKN(n) (wq + ((n) < cnt ? (n) : cnt - 1) * nwq)
    unsigned idA, idB; u32x4 rA[16], rB[16]; unsigned ccA, ccB, xdA, xdB;
    PB_LOAD_ID(idA, TOKN(0)); PB_LOAD_ID(idB, TOKN(1)); PB_LOAD_CC(ccA, xdA, TOKN(0)); PB_LOAD_CC(ccB, xdB, TOKN(1)); PB_ISSUE(rA, idA); PB_ISSUE(rB, idB);
    PB_LOAD_ID(idA, TOKN(2)); PB_LOAD_ID(idB, TOKN(3));
#define PB_STEP(R, ID, CC, XD, n_, guard) do { \
        const float sc_ = __builtin_bit_cast(float, __builtin_amdgcn_readlane((int)CC, 32)); const unsigned xr_ = XD; \
        *(LAS unsigned*)(wsm + lane * 4) = CC; const u32x4 cq_ = *(const LAS u32x4*)(wsm + g * 16); \
        int acc[16]; _Pragma("unroll") for (int i_ = 0; i_ < 16; ++i_) acc[i_] = 0; \
        PB_BLK(R, 0, cq_.x); PB_BLK(R, 1, cq_.y); PB_BLK(R, 2, cq_.z); PB_BLK(R, 3, cq_.w); \
        __builtin_amdgcn_sched_barrier(0); \
        PB_ISSUE(R, ID); PB_LOAD_ID(ID, TOKN((n_) + 4)); PB_LOAD_CC(CC, XD, TOKN((n_) + 2)); \
        __builtin_amdgcn_sched_barrier(0); \
        if (guard) { int v_[8], w_[4], z_[2]; \
            _Pragma("unroll") for (int i_ = 0; i_ < 8; ++i_) { const int keep_ = b3 ? acc[8 + i_] : acc[i_], send_ = b3 ? acc[i_] : acc[8 + i_]; v_[i_] = keep_ + __builtin_amdgcn_update_dpp(0, send_, 0x128, 0xf, 0xf, true); } \
            _Pragma("unroll") for (int i_ = 0; i_ < 4; ++i_) { auto r_ = __builtin_amdgcn_permlane16_swap((unsigned)v_[i_], (unsigned)v_[4 + i_], false, false); w_[i_] = (int)(r_[0] + r_[1]); } \
            _Pragma("unroll") for (int i_ = 0; i_ < 2; ++i_) { auto r_ = __builtin_amdgcn_permlane32_swap((unsigned)w_[i_], (unsigned)w_[2 + i_], false, false); z_[i_] = (int)(r_[0] + r_[1]); } \
            f32x2 o_; o_.x = bflo(xr_) + sc_ * (float)z_[0]; o_.y = bfhi(xr_) + sc_ * (float)z_[1]; \
            *(f32x2*)(F.out + (size_t)TOKN(n_) * D + ochan) = o_; } \
        __builtin_amdgcn_sched_barrier(0); } while (0)
#define PB_STEP_A(n_, guard) PB_STEP(rA, idA, ccA, xdA, n_, guard)
#define PB_STEP_B(n_, guard) PB_STEP(rB, idB, ccB, xdB, n_, guard)
    int n = 0;
    for (; n + 8 <= cnt; n += 8) { PB_STEP_A(n, true); PB_STEP_B(n + 1, true); PB_STEP_A(n + 2, true); PB_STEP_B(n + 3, true); PB_STEP_A(n + 4, true); PB_STEP_B(n + 5, true); PB_STEP_A(n + 6, true); PB_STEP_B(n + 7, true); }
    for (; n < cnt; n += 2) { PB_STEP_A(n, true); PB_STEP_B(n + 1, n + 1 < cnt); }
#undef PB_STEP
#undef PB_STEP_A
#undef PB_STEP_B
#undef TOKN
}

__global__ void __launch_bounds__(NTHR, 2) fwd_kernel(Args args) {
    extern __shared__ __attribute__((aligned(16))) unsigned char lds_raw[];
    Ctx F;
    F.lds = (LAS unsigned char*)lds_raw;
    F.tid = threadIdx.x; F.lane = F.tid & 63; F.wave = __builtin_amdgcn_readfirstlane(F.tid >> 6); F.G = gridDim.x; F.bid = blockIdx.x;
    F.x = args.in[0]; F.g1 = args.in[1]; F.w_in = args.in[2]; F.gate_bias = args.in[3]; F.qgain = args.in[4]; F.kgain = args.in[5]; F.sinks = args.in[6];
    F.w_up_a = args.in[7]; F.w_up_b = args.in[8]; F.w_out = args.in[9]; F.g2 = args.in[10]; F.w_q = args.in[11]; F.sub_keys = args.in[12]; F.pu = args.in[13]; F.pv = args.in[14];
    F.out = args.out; F.ws = args.ws;
    unsigned char* ws = args.ws;
    const int lo = args.ph_lo, hi = args.ph_hi;
    XcdBarrier xbar; xbar.bar = (unsigned*)ws; xbar.x = 0; xbar.st = nullptr;
    if (hi - lo > 1) {
        volatile LAS unsigned* st = (volatile LAS unsigned*)(F.lds + LDS_BYTES - 64);
        if (F.tid < 2) st[F.tid] = 0u;
        __syncthreads();
        xbar = xcd_barrier_post((unsigned*)ws, st);
    }
#ifdef ONLY_PHASE
#define IN(k) ((k) == ONLY_PHASE)
#else
#define IN(k) (lo <= (k) && (k) < hi)
#endif
#define SEAM(k) do { if (IN(k) && IN((k) + 1)) { xcd_barrier(xbar); } } while (0)
#define RUNP(k, ...) do { if (IN(k)) { __VA_ARGS__ if (REP_PHASE == (k)) { __VA_ARGS__ } } } while (0)
    RUNP(0, p0_prep(F););
    SEAM(0);
    RUNP(1,
        LAS float* gbl = (LAS float*)(F.lds + 131072);
        for (int i = F.tid; i < 2048; i += NTHR) gbl[i] = F.gate_bias[i];
        __syncthreads();
        { pg8::Gemm g{(const bf16*)(ws + WS_H), (const bf16*)(ws + WS_W1T), MTOK, 1024, D, D, D}; pg8::StaticOrder S; S.init(MTOK, 1024, F.G, F.bid);
          Epi1Map E{ws, gbl, 1.f, 1.f, 0, (3 << 16) | 3}; pg8::gemm_phase<Epi1Map, pg8::StaticOrder>(F.lds, g, S, E); }
        { pg8::Gemm g{(const bf16*)(ws + WS_H8), (const bf16*)(ws + WS_WG8T), MTOK, 2816, D / 2, D / 2, D / 2}; pg8::StaticOrder S; S.init(MTOK, 2816, F.G, F.bid);
          Epi1Map E{ws, gbl, 1.f / 64.f, 1.f / 64.f, 3, (4 << 16) | 0}; pg8::gemm_phase_fp8<Epi1Map, pg8::StaticOrder>(F.lds, g, S, E); }
        { pg8::Gemm g{(const bf16*)(ws + WS_WVBT), (const bf16*)(ws + WS_H), 512, MTOK, D, D, D}; pg8::StaticOrder S; S.init(512, MTOK, F.G, F.bid);
          EpiStore<false> E{(unsigned short*)(ws + WS_VBT), MTOK}; pg8::gemm_phase<EpiStore<false>, pg8::StaticOrder>(F.lds, g, S, E); }
    );
    SEAM(1);
    RUNP(2, swa_phase(F); if (REP_PHASE == 20) swa_phase(F); sb_phase(F); if (REP_PHASE == 21) sb_phase(F););
    SEAM(2);
    RUNP(3,
        { pg8::Gemm g{(const bf16*)(ws + WS_H), (const bf16*)(ws + WS_WUPT), MTOK, D, 512, D, D}; pg8::StaticOrder S; S.init(MTOK, D, F.G, F.bid);
          EpiUpChain E{ws + WS_GATES, ws + WS_M8}; pg8::gemm_phase<EpiUpChain, pg8::StaticOrder, true>(F.lds, g, S, E, 1024); }
    );
    SEAM(3);
    RUNP(4,
        { pg8::Gemm g{(const bf16*)(ws + WS_M8), (const bf16*)(ws + WS_WOUT8T), MTOK, D, D / 2, D / 2, D / 2}; pg8::StaticOrder S; S.init(MTOK, D, F.G, F.bid);
          EpiOut E{F.x, F.out, (bf16*)(ws + WS_H), (float*)(ws + WS_SSQ), 1.f / 64.f}; pg8::gemm_phase_fp8<EpiOut, pg8::StaticOrder>(F.lds, g, S, E); }
    );
    SEAM(4);
    RUNP(5,
        { pg8::Gemm g{(const bf16*)(ws + WS_H), (const bf16*)(ws + WS_WST), MTOK, 2048, D, D, D}; pg8::StaticOrder S; S.init(MTOK, 2048, F.G, F.bid, P5_WGM);
          EpiTopK E{F.lds + 131072, (unsigned*)(ws + WS_GATES)}; pg8::gemm_phase<EpiTopK, pg8::StaticOrder>(F.lds, g, S, E); }
    );
    SEAM(5);
    RUNP(6, peer_select_phase(F););
    SEAM(6);
    RUNP(7, peer_dot_phase(F););
    SEAM(7);
    RUNP(8, peer_coef_phase(F););
    SEAM(8);
    RUNP(9, peer_axpy_phase(F););
#undef IN
#undef SEAM
}

extern "C" void kernel_launch(void* const* d_in, const int* in_sizes, int n_in, void* d_out, int out_size, void* d_ws, size_t ws_size, hipStream_t stream) {
    static int grid = 0;
    if (grid == 0) {
        if (n_in != 15 || out_size != MTOK * D || ws_size < WS_END) { fprintf(stderr, "kernel_launch: unexpected shapes (n_in %d out %d ws %zu)\n", n_in, out_size, ws_size); grid = -1; return; }
        int dev = 0, cus = 0, per_cu = 0;
        hipGetDevice(&dev); hipDeviceGetAttribute(&cus, hipDeviceAttributeMultiprocessorCount, dev);
        hipFuncSetAttribute((const void*)fwd_kernel, hipFuncAttributeMaxDynamicSharedMemorySize, LDS_BYTES);
        hipOccupancyMaxActiveBlocksPerMultiprocessor(&per_cu, (const void*)fwd_kernel, NTHR, LDS_BYTES);
        if (per_cu < 1) { fprintf(stderr, "kernel_launch: occupancy query says %d blocks per CU\n", per_cu); per_cu = 1; }
        grid = cus;
        (void)hipGetLastError();
    }
    if (grid < 0) return;
    if (hipMemsetAsync(d_ws, 0, 16384, stream) != hipSuccess) { fprintf(stderr, "kernel_launch: memset of the barrier words failed\n"); return; }
    Args a{};
    for (int i = 0; i < 15; ++i) a.in[i] = (const float*)d_in[i];
    a.out = (float*)d_out; a.ws = (unsigned char*)d_ws;
#if N_LAUNCH == 1
    a.ph_lo = 0; a.ph_hi = 10;
    void* kargs[] = {&a};
    hipError_t e = hipLaunchCooperativeKernel((const void*)fwd_kernel, dim3(grid), dim3(NTHR), kargs, LDS_BYTES, stream);
    if (e != hipSuccess) fprintf(stderr, "cooperative launch failed: %s (grid %d)\n", hipGetErrorString(e), grid);
#else
    for (int p = 0; p < 10; ++p) { a.ph_lo = p; a.ph_hi = p + 1; hipLaunchKernelGGL(fwd_kernel, dim3(grid), dim3(NTHR), LDS_BYTES, stream, a); }
#endif
}
```
